# Optimizing an MI355X kernel written in HIP

```python
import jax, jax.numpy as jnp
from jax import lax
import numpy as np

D_MODEL = 1024
BATCH = 32
SEQ = 2048
DEPTH = 1

MLA_HEADS = 8
MLA_NOPE = 64
MLA_ROPE = 32
MLA_V = 64
Q_LORA = 384
KV_LORA = 256
MLA_WIDTH = MLA_HEADS * MLA_V

SWA_HEADS = 8
SWA_KV_HEADS = 2
SWA_HEAD_DIM = 64
SWA_GROUP = SWA_HEADS // SWA_KV_HEADS
SWA_WIDTH = SWA_HEADS * SWA_HEAD_DIM
SWA_KV_WIDTH = SWA_KV_HEADS * SWA_HEAD_DIM
WINDOW = 128

D_MIX = MLA_WIDTH + SWA_WIDTH
Q_BLOCK = 128
ROPE_THETA = 10000.0
EPS = 1e-6
ALIBI_MAX_EXP = 8.0

IN_SPLITS = (Q_LORA, KV_LORA, MLA_ROPE, MLA_WIDTH,
             SWA_WIDTH, SWA_KV_WIDTH, SWA_KV_WIDTH, SWA_WIDTH)
D_IN = int(sum(IN_SPLITS))
SPLIT_IDX = [int(v) for v in np.cumsum(IN_SPLITS)[:-1]]

kernel_name = 'hymba_mla_swa_adaln_block'


def rmsnorm(t, gain):
    tf = t.astype(jnp.float32)
    y = tf * lax.rsqrt(jnp.mean(tf * tf, axis=-1, keepdims=True) + EPS)
    return (y * gain.astype(jnp.float32)).astype(t.dtype)


def rope_cos_sin(positions):
    inv = ROPE_THETA ** (-jnp.arange(0, MLA_ROPE, 2, dtype=jnp.float32) / MLA_ROPE)
    ang = positions.astype(jnp.float32)[..., None] * inv
    return jnp.cos(ang), jnp.sin(ang)


def apply_rope(t, cos, sin):
    tf = t.astype(jnp.float32)
    t1, t2 = jnp.split(tf, 2, axis=-1)
    return jnp.concatenate([t1 * cos - t2 * sin, t2 * cos + t1 * sin], axis=-1).astype(t.dtype)


def alibi_slopes(n_heads):
    h = jnp.arange(1, n_heads + 1, dtype=jnp.float32)
    return 2.0 ** (-ALIBI_MAX_EXP * h / n_heads)


def mla_attention(q_nope, q_pe, k_nope, k_pe, v):
    B, S = q_nope.shape[0], q_nope.shape[1]
    nb = S // Q_BLOCK
    scale = (MLA_NOPE + MLA_ROPE) ** -0.5
    key_idx = jnp.arange(S)

    def to_blocks(t):
        return jnp.moveaxis(t.reshape(B, nb, Q_BLOCK, *t.shape[2:]), 1, 0)

    def one_block(args):
        qn, qp, blk = args
        s = (jnp.einsum('bqhd,bshd->bhqs', qn, k_nope, preferred_element_type=jnp.float32)
             + jnp.einsum('bqhr,bsr->bhqs', qp, k_pe, preferred_element_type=jnp.float32)) * scale
        q_idx = blk * Q_BLOCK + jnp.arange(Q_BLOCK)
        s = jnp.where(key_idx[None, :] <= q_idx[:, None], s, -jnp.inf)
        p = jax.nn.softmax(s, axis=-1).astype(v.dtype)
        return jnp.einsum('bhqs,bshd->bqhd', p, v)

    o = lax.map(one_block, (to_blocks(q_nope), to_blocks(q_pe), jnp.arange(nb)))
    return jnp.moveaxis(o, 0, 1).reshape(B, S, MLA_WIDTH)


def swa_attention(q, k, v, positions, slopes, sinks):
    B, S = q.shape[0], q.shape[1]
    nb = S // WINDOW
    scale = SWA_HEAD_DIM ** -0.5

    def band(t):
        tb = t.reshape(B, nb, WINDOW, *t.shape[2:])
        prev = jnp.concatenate([jnp.zeros_like(tb[:, :1]), tb[:, :-1]], axis=1)
        return jnp.concatenate([prev, tb], axis=2)

    qb = q.reshape(B, nb, WINDOW, SWA_KV_HEADS, SWA_GROUP, SWA_HEAD_DIM)
    kb = band(k.reshape(B, S, SWA_KV_HEADS, SWA_HEAD_DIM))
    vb = band(v.reshape(B, S, SWA_KV_HEADS, SWA_HEAD_DIM))
    s = jnp.einsum('bnqkgd,bnskd->bnkgqs', qb, kb, preferred_element_type=jnp.float32) * scale
    pq = positions.reshape(B, nb, WINDOW)
    pk = band(positions)
    dist = (pq[..., :, None] - pk[..., None, :]).astype(jnp.float32)
    s = s - slopes.reshape(SWA_KV_HEADS, SWA_GROUP)[None, None, :, :, None, None] * dist[:, :, None, None]
    i = jnp.arange(WINDOW)[:, None]
    j = jnp.arange(2 * WINDOW)[None, :]
    rel = WINDOW + i - j
    blk = jnp.arange(nb)[:, None, None]
    valid = (rel >= 0) & (rel < WINDOW) & ((blk > 0) | (j >= WINDOW))
    s = jnp.where(valid[None, :, None, None], s, -jnp.inf)
    sink = jnp.broadcast_to(sinks.astype(jnp.float32).reshape(SWA_KV_HEADS, SWA_GROUP)[None, None, :, :, None, None],
                            s.shape[:-1] + (1,))
    p = jax.nn.softmax(jnp.concatenate([s, sink], axis=-1), axis=-1)[..., :-1].astype(v.dtype)
    o = jnp.einsum('bnkgqs,bnskd->bnqkgd', p, vb)
    return o.reshape(B, S, SWA_WIDTH)


def setup_inputs(seed: int = 0) -> dict:
    key = jax.random.key(seed)
    ks = jax.random.split(key, 16)
    f32 = jnp.float32
    nrm = lambda k, shape, s: jax.random.normal(k, shape, f32) * s
    x = jax.random.normal(ks[0], (BATCH, SEQ, D_MODEL), f32)
    c = jax.random.normal(ks[1], (BATCH, D_MODEL), f32)
    offs = jax.random.randint(ks[2], (BATCH, 1), 0, 1024, dtype=jnp.int32)
    positions = offs + jnp.arange(SEQ, dtype=jnp.int32)[None, :]
    return {
        'x': x,
        'c': c,
        'positions': positions,
        'w_ada': nrm(ks[3], (DEPTH, D_MODEL, 3 * D_MODEL), D_MODEL ** -0.5),
        'b_ada': nrm(ks[4], (DEPTH, 3 * D_MODEL), 0.02),
        'norm_gain': 1.0 + nrm(ks[5], (DEPTH, D_MODEL), 0.02),
        'w_in': nrm(ks[6], (DEPTH, D_MODEL, D_IN), D_MODEL ** -0.5),
        'q_norm_gain': 1.0 + nrm(ks[7], (DEPTH, Q_LORA), 0.02),
        'kv_norm_gain': 1.0 + nrm(ks[8], (DEPTH, KV_LORA), 0.02),
        'w_uq': nrm(ks[9], (DEPTH, Q_LORA, MLA_HEADS * (MLA_NOPE + MLA_ROPE)), Q_LORA ** -0.5),
        'w_ukv': nrm(ks[10], (DEPTH, KV_LORA, MLA_HEADS * (MLA_NOPE + MLA_V)), KV_LORA ** -0.5),
        'swa_sinks': nrm(ks[11], (DEPTH, SWA_HEADS), 1.0),
        'w_out': nrm(ks[12], (DEPTH, D_MIX, D_MODEL), D_MIX ** -0.5),
        'final_gain': 1.0 + nrm(ks[13], (D_MODEL,), 0.02),
    }


def reference(x, c, positions, w_ada, b_ada, norm_gain, w_in, q_norm_gain, kv_norm_gain,
              w_uq, w_ukv, swa_sinks, w_out, final_gain):
    B, S, _ = x.shape
    cos, sin = rope_cos_sin(positions)
    slopes = alibi_slopes(SWA_HEADS)
    c_act = jax.nn.silu(c)
    for l in range(DEPTH):
        mod = c_act @ w_ada[l] + b_ada[l]
        shift, scale, gate = jnp.split(mod, 3, axis=-1)
        h = rmsnorm(x, norm_gain[l]) * (1.0 + scale[:, None, :]) + shift[:, None, :]
        z = h @ w_in[l]
        zq, zkv, kr, g_mla, q_s, k_s, v_s, g_swa = jnp.split(z, SPLIT_IDX, axis=-1)
        q = (rmsnorm(zq, q_norm_gain[l]) @ w_uq[l]).reshape(B, S, MLA_HEADS, MLA_NOPE + MLA_ROPE)
        q_nope, q_pe = q[..., :MLA_NOPE], apply_rope(q[..., MLA_NOPE:], cos[:, :, None, :], sin[:, :, None, :])
        kv = (rmsnorm(zkv, kv_norm_gain[l]) @ w_ukv[l]).reshape(B, S, MLA_HEADS, MLA_NOPE + MLA_V)
        k_nope, v_mla = kv[..., :MLA_NOPE], kv[..., MLA_NOPE:]
        k_pe = apply_rope(kr, cos, sin)
        o_mla = mla_attention(q_nope, q_pe, k_nope, k_pe, v_mla).astype(x.dtype)
        o_swa = swa_attention(q_s, k_s, v_s, positions, slopes, swa_sinks[l]).astype(x.dtype)
        y = jnp.concatenate([o_mla * jax.nn.silu(g_mla), o_swa * jax.nn.silu(g_swa)], axis=-1) @ w_out[l]
        x = x + gate[:, None, :] * y
    return rmsnorm(x, final_gain)
```

```cpp
#include <hip/hip_runtime.h>
#include <hip/hip_cooperative_groups.h>
#include <cstdio>
#include <cstdint>
namespace cg = cooperative_groups;
__device__ __forceinline__ int lane_id_v() { int l; asm volatile("v_mbcnt_lo_u32_b32 %0, -1, 0\n\tv_mbcnt_hi_u32_b32 %0, -1, %0" : "=v"(l)); return l; }
namespace pg8 {
#define PG8_LAS __attribute__((address_space(3)))
typedef unsigned short bf16_t;
typedef short bf16x8 __attribute__((ext_vector_type(8)));
typedef float f32x4 __attribute__((ext_vector_type(4)));
typedef unsigned u32x4 __attribute__((ext_vector_type(4)));
constexpr int BM = 256, BK = 64, HALF = 128, HTB = HALF * BK * 2  , STAGE_BYTES = 8 * HTB, NXCD = 8, WGM = 8;

__host__ __device__ __forceinline__ int lds_byte(int r, int c) { const int st = (r >> 4) * 2 + (c >> 5), rr = r & 15, cc = c & 31, ob = rr * 64 + cc * 2; return st * 1024 + (ob ^ (((ob >> 9) & 1) << 5)); }
__host__ __device__ __forceinline__ void stage_rc(int b, int& R, int& C) { const int st = b / 1024, sb = b % 1024, swz = sb ^ (((sb >> 9) & 1) << 5); R = (st >> 1) * 16 + swz / 64; C = (st & 1) * 32 + (swz % 64) / 2; }
__host__ __device__ __forceinline__ int perm32(int rho) { const int n = rho >> 4, i = rho & 15; return 8 * (i >> 2) + 4 * n + (i & 3); }

struct Unit { int pm, pn; };
struct Gemm { const bf16_t* A; const bf16_t* Bt; int M, N, K, lda; };

struct StaticOrder {
    int nM, nN, nwg, G, c;
    __host__ __device__ void init(int M, int N, int G_, int c_) { nM = M / BM; nN = N / BM; nwg = nM * nN; G = G_; c = c_; }
    __host__ __device__ bool next(int i, Unit& u) const {
        const long L = (long)i * G + c; if (L >= nwg) return false;
        int wgid = (int)L; { const int q = nwg / NXCD, r = nwg % NXCD, xcd = wgid % NXCD, off = wgid / NXCD; wgid = (xcd < r ? xcd * (q + 1) : r * (q + 1) + (xcd - r) * q) + off; }
        const int nig = WGM * nN, gid = wgid / nig, fm = gid * WGM, gsz = (nM - fm) < WGM ? (nM - fm) : WGM;
        u.pm = fm + ((wgid % nig) % gsz); u.pn = (wgid % nig) / gsz; return true;
    }
    __device__ __forceinline__ void a_ready(const Unit&) const {}
    __device__ __forceinline__ void done(const Unit&) const {}
};

__device__ __forceinline__ unsigned cvt_pk_bf16(float lo, float hi) { unsigned r; asm volatile("v_cvt_pk_bf16_f32 %0, %1, %2" : "=v"(r) : "v"(lo), "v"(hi)); return r; }
typedef float f32x2 __attribute__((ext_vector_type(2)));
template <class Epi, class Sched, bool ALIGN_EPI = false, bool SP2 = false>
__device__ __forceinline__ void gemm_phase(PG8_LAS unsigned char* lds, const Gemm g, const Sched& S, const Epi& E, int wid_in) {
    const int wid = wid_in, lane = lane_id_v(), tid = wid * 64 + lane, wr = wid >> 2, wc = wid & 3, fr = lane & 15, fq = lane >> 4;
    int K_ = g.K; asm volatile("" : "+s"(K_));
    const int K = K_, nt = K / BK;
    unsigned voffA[2], voffB[2];
#pragma unroll
    for (int i = 0; i < 2; ++i) { int R, C; stage_rc(tid * 16 + i * 8192, R, C); const int Rb = Epi::PERM ? ((R & ~31) + perm32(R & 31)) : R;
        voffA[i] = (unsigned)(R * g.lda + C) * 2u; voffB[i] = (unsigned)(Rb * K + C) * 2u; }
    const size_t kstep = (size_t)(BK * 2);
    const size_t hstepB = (size_t)HALF * K * 2, hstepA = (size_t)HALF * g.lda * 2;
    const size_t tstepA = 2 * hstepA, tstepB = 2 * hstepB;
    const unsigned ldsw = (unsigned)wid * 1024u;
    const int aoff = lds_byte(wr * 64 + fr, fq * 8), boff = lds_byte(wc * 32 + fr, fq * 8);
#define PG8_SA(b, h) (((b) * 2 + (h)) * HTB)
#define PG8_SB(b, h) ((4 + (b) * 2 + (h)) * HTB)
#define PG8_STAGE(bufoff, gbase, voff) do { _Pragma("unroll") for (int _i = 0; _i < 2; ++_i) \
        __builtin_amdgcn_global_load_lds((const unsigned*)((const char*)(gbase) + (voff)[_i]), (PG8_LAS unsigned*)(lds + (bufoff) + ldsw + _i * 8192), 16, 0, 0); } while (0)
#define PG8_LDA(dst, b, h) do { _Pragma("unroll") for (int m = 0; m < 4; ++m) _Pragma("unroll") for (int k = 0; k < 2; ++k) dst[m][k] = *(const PG8_LAS bf16x8*)(lds + PG8_SA(b, h) + aoff + m * 2048 + k * 1024); } while (0)
#define PG8_LDB(dst, b, h) do { _Pragma("unroll") for (int n = 0; n < 2; ++n) _Pragma("unroll") for (int k = 0; k < 2; ++k) dst[n][k] = *(const PG8_LAS bf16x8*)(lds + PG8_SB(b, h) + boff + n * 2048 + k * 1024); } while (0)
#define PG8_MMA(ai, bj, At, Bt) do { __builtin_amdgcn_s_setprio(1); _Pragma("unroll") for (int m = 0; m < 4; ++m) _Pragma("unroll") for (int n = 0; n < 2; ++n) _Pragma("unroll") for (int k = 0; k < 2; ++k) \
        acc[ai][bj][m][n] = __builtin_amdgcn_mfma_f32_16x16x32_bf16(Bt[n][k], At[m][k], acc[ai][bj][m][n], 0, 0, 0); __builtin_amdgcn_s_setprio(0); } while (0)
#define PG8_WAIT_V(n) asm volatile("s_waitcnt vmcnt(" #n ")" ::: "memory")
#define PG8_WAIT_L(n) asm volatile("s_waitcnt lgkmcnt(" #n ")" ::: "memory")
#define PG8_BAR __builtin_amdgcn_s_barrier()
#define PG8_SCHED __builtin_amdgcn_sched_barrier(0)
    Unit cur, nxt; int ui = 0;
    if (!S.next(0, cur)) return;
    f32x4 acc[2][2][4][2];
#pragma unroll
    for (int a = 0; a < 2; ++a)
#pragma unroll
        for (int b = 0; b < 2; ++b)
#pragma unroll
            for (int m = 0; m < 4; ++m)
#pragma unroll
                for (int n = 0; n < 2; ++n) acc[a][b][m][n] = (f32x4){0.f, 0.f, 0.f, 0.f};
    bf16x8 At[4][2], B0[2][2], B1[2][2];
    const char* cA = (const char*)g.A + (size_t)cur.pm * tstepA; const char* cB = (const char*)g.Bt + (size_t)cur.pn * tstepB;
    S.a_ready(cur);
    if constexpr (SP2) {
        PG8_STAGE(PG8_SB(0, 0), cB, voffB); PG8_STAGE(PG8_SB(0, 1), cB + hstepB, voffB); PG8_STAGE(PG8_SA(0, 0), cA, voffA); PG8_STAGE(PG8_SA(0, 1), cA + hstepA, voffA);
        if (wr == 1) PG8_BAR;
        PG8_WAIT_V(2); PG8_BAR;
        PG8_STAGE(PG8_SB(1, 0), cB + kstep, voffB); PG8_STAGE(PG8_SA(1, 0), cA + kstep, voffA); PG8_STAGE(PG8_SB(1, 1), cB + hstepB + kstep, voffB);
        PG8_WAIT_V(6); PG8_BAR;
    } else {
        PG8_STAGE(PG8_SB(0, 0), cB, voffB); PG8_STAGE(PG8_SA(0, 0), cA, voffA); PG8_STAGE(PG8_SB(0, 1), cB + hstepB, voffB); PG8_STAGE(PG8_SA(0, 1), cA + hstepA, voffA);
        if (wr == 1) PG8_BAR;
        PG8_WAIT_V(4); PG8_BAR;
        PG8_STAGE(PG8_SB(1, 0), cB + kstep, voffB); PG8_STAGE(PG8_SA(1, 0), cA + kstep, voffA); PG8_STAGE(PG8_SB(1, 1), cB + hstepB + kstep, voffB);
        PG8_WAIT_V(6); PG8_BAR;
    }
    for (;;) {
        const bool has_next = S.next(ui + 1, nxt);
        const char* nA = has_next ? (const char*)g.A + (size_t)nxt.pm * tstepA : cA; const char* nB = has_next ? (const char*)g.Bt + (size_t)nxt.pn * tstepB : cB;
        _Pragma("nounroll") for (int t = 0; t < nt; t += 2) {
            const bool last = (t == nt - 2);
            const char* a1 = cA + (size_t)(t + 1) * kstep;
            const char* a2 = last ? nA : cA + (size_t)(t + 2) * kstep; const char* b2 = last ? nB : cB + (size_t)(t + 2) * kstep;
            const char* a3 = a2 + kstep; const char* b3 = b2 + kstep;
            if (last && has_next) S.a_ready(nxt);
            if constexpr (SP2) {
            PG8_LDB(B0, 0, 0); PG8_LDB(B1, 0, 1); PG8_SCHED; PG8_LDA(At, 0, 0); PG8_STAGE(PG8_SA(1, 1), a1 + hstepA, voffA);
            PG8_WAIT_V(8); PG8_WAIT_L(0); PG8_BAR; PG8_MMA(0, 0, At, B0); PG8_MMA(0, 1, At, B1); PG8_BAR; PG8_SCHED;
            PG8_LDA(At, 0, 1); PG8_STAGE(PG8_SB(0, 0), b2, voffB); PG8_STAGE(PG8_SB(0, 1), b2 + hstepB, voffB); PG8_STAGE(PG8_SA(0, 0), a2, voffA);
            PG8_WAIT_V(8); PG8_WAIT_L(0); PG8_BAR; PG8_MMA(1, 0, At, B0); PG8_MMA(1, 1, At, B1); PG8_BAR; PG8_SCHED;
            PG8_LDB(B0, 1, 0); PG8_LDB(B1, 1, 1); PG8_SCHED; PG8_LDA(At, 1, 0); PG8_STAGE(PG8_SA(0, 1), a2 + hstepA, voffA);
            PG8_WAIT_V(8); PG8_WAIT_L(0); PG8_BAR; PG8_MMA(0, 0, At, B0); PG8_MMA(0, 1, At, B1); PG8_BAR; PG8_SCHED;
            PG8_LDA(At, 1, 1); PG8_STAGE(PG8_SB(1, 0), b3, voffB); PG8_STAGE(PG8_SB(1, 1), b3 + hstepB, voffB); PG8_STAGE(PG8_SA(1, 0), a3, voffA);
            PG8_WAIT_V(8); PG8_WAIT_L(0); PG8_BAR; PG8_MMA(1, 0, At, B0); PG8_MMA(1, 1, At, B1); PG8_BAR; PG8_SCHED;
            } else {
            PG8_LDB(B0, 0, 0); PG8_SCHED; PG8_LDA(At, 0, 0); PG8_STAGE(PG8_SA(1, 1), a1 + hstepA, voffA);
            PG8_WAIT_L(8); PG8_BAR; PG8_WAIT_L(0); PG8_MMA(0, 0, At, B0); PG8_BAR; PG8_SCHED;
            PG8_LDB(B1, 0, 1); PG8_STAGE(PG8_SB(0, 0), b2, voffB);
            PG8_BAR; PG8_WAIT_L(0); PG8_MMA(0, 1, At, B1); PG8_BAR;
            PG8_LDA(At, 0, 1); PG8_STAGE(PG8_SA(0, 0), a2, voffA);
            PG8_BAR; PG8_WAIT_L(0); PG8_MMA(1, 0, At, B0); PG8_BAR; PG8_SCHED;
            PG8_STAGE(PG8_SB(0, 1), b2 + hstepB, voffB);
            PG8_WAIT_V(6); PG8_BAR; PG8_MMA(1, 1, At, B1); PG8_BAR;
            PG8_LDB(B0, 1, 0); PG8_SCHED; PG8_LDA(At, 1, 0); PG8_STAGE(PG8_SA(0, 1), a2 + hstepA, voffA);
            PG8_WAIT_L(8); PG8_BAR; PG8_WAIT_L(0); PG8_MMA(0, 0, At, B0); PG8_BAR; PG8_SCHED;
            PG8_LDB(B1, 1, 1); PG8_STAGE(PG8_SB(1, 0), b3, voffB);
            PG8_BAR; PG8_WAIT_L(0); PG8_MMA(0, 1, At, B1); PG8_BAR;
            PG8_LDA(At, 1, 1); PG8_STAGE(PG8_SA(1, 0), a3, voffA);
            PG8_BAR; PG8_WAIT_L(0); PG8_MMA(1, 0, At, B0); PG8_BAR; PG8_SCHED;
            PG8_STAGE(PG8_SB(1, 1), b3 + hstepB, voffB);
            PG8_WAIT_V(6); PG8_BAR; PG8_MMA(1, 1, At, B1); PG8_BAR;
            }
        }
        if constexpr (ALIGN_EPI) { if (wr == 0) PG8_BAR; }
        if constexpr (!Epi::AFTER_DRAIN) { E(acc, cur, wr, wc, fr, fq); S.done(cur); }
        if (!has_next) break;
#pragma unroll
        for (int a = 0; a < 2; ++a)
#pragma unroll
            for (int b = 0; b < 2; ++b)
#pragma unroll
                for (int m = 0; m < 4; ++m)
#pragma unroll
                    for (int n = 0; n < 2; ++n) acc[a][b][m][n] = (f32x4){0.f, 0.f, 0.f, 0.f};
        cur = nxt; cA = nA; cB = nB; ++ui;
        if constexpr (ALIGN_EPI) { if (wr == 1) PG8_BAR; }
    }
    PG8_WAIT_V(0);
    if constexpr (!ALIGN_EPI) { if (wr == 0) PG8_BAR; }
    PG8_BAR;
    if constexpr (Epi::AFTER_DRAIN) { E.fused(acc, cur, wr, wc, fr, fq, lds, wid, lane); S.done(cur); }
#undef PG8_SA
#undef PG8_SB
#undef PG8_STAGE
#undef PG8_LDA
#undef PG8_LDB
#undef PG8_MMA
#undef PG8_WAIT_V
#undef PG8_WAIT_L
#undef PG8_BAR
#undef PG8_SCHED
}
}
#define LAS __attribute__((address_space(3)))
typedef unsigned short bf16;
typedef short bf16x8 __attribute__((ext_vector_type(8)));
typedef short s16x4 __attribute__((ext_vector_type(4)));
typedef float f32x4 __attribute__((ext_vector_type(4)));
typedef float f32x16 __attribute__((ext_vector_type(16)));
typedef unsigned u32x4 __attribute__((ext_vector_type(4)));
typedef unsigned u32x2 __attribute__((ext_vector_type(2)));

constexpr int NB = 32, SEQ = 2048, DM = 1024, MTOK = NB * SEQ;
constexpr int NZ = 2560;
constexpr int ZKV_OFF = 0, GMLA_OFF = 256, QS_OFF = 768, KS_OFF = 1280, VS_OFF = 1408, GSWA_OFF = 1536, ZQ_OFF = 2048, KR_OFF = 2432, NZ_USED = 2464;
constexpr int NQ = 768, NKV = 1024, QLORA = 384, KVLORA = 256;
constexpr float EPSN = 1e-6f;
constexpr float LOG2E = 1.4426950408889634f;
constexpr float C2Q = 0.10206207261596577f * 1.4426950408889634f;

constexpr size_t MiB = 1u << 20;
constexpr size_t WS_WIN = 0, WS_WUQ = 6 * MiB, WS_WUKV = 7 * MiB, WS_WOUT = 8 * MiB, WS_MOD = 10 * MiB;
constexpr size_t WS_SSQ = 13 * MiB, WS_SSKV = WS_SSQ + 256 * 1024, WS_ROWSS = WS_SSKV + 256 * 1024;
constexpr size_t WS_CS = 16 * MiB, WS_KPE = 24 * MiB, WS_H = 32 * MiB, WS_Y = WS_H, WS_Z = 160 * MiB, WS_Q = 480 * MiB, WS_KV = 576 * MiB, WS_END = 704 * MiB;

constexpr int LDS_BYTES = 147456;

__device__ __forceinline__ unsigned pk_bf16(float lo, float hi) { typedef float f2_t __attribute__((ext_vector_type(2))); typedef __bf16 b2_t __attribute__((ext_vector_type(2)));
    f2_t v = {lo, hi}; b2_t b = __builtin_convertvector(v, b2_t); return __builtin_bit_cast(unsigned, b); }
__device__ __forceinline__ float bf_lo(unsigned u) { return __uint_as_float(u << 16); }
__device__ __forceinline__ float bf_hi(unsigned u) { return __uint_as_float(u & 0xffff0000u); }
__device__ __forceinline__ float silu_f(float g) { return g * __builtin_amdgcn_rcpf(1.f + __builtin_amdgcn_exp2f(-g * LOG2E)); }
__device__ __forceinline__ float wave_sum(float v) {
#pragma unroll
    for (int o = 1; o < 64; o <<= 1) v += __shfl_xor(v, o);
    return v;
}
#define LDS_WAIT() asm volatile("s_waitcnt lgkmcnt(0)" ::: "memory")

namespace pg8 {
struct EpiZ {
    static constexpr bool PERM = true, AFTER_DRAIN = false;
    bf16_t* Zp; float* ssq; float* sskv;
    __device__ __forceinline__ void operator()(const f32x4 (&acc)[2][2][4][2], const Unit& u, int wr, int wc, int fr, int fq) const {
        const int row0 = u.pm * BM + wr * 64 + fr, col0 = u.pn * BM + wc * 32 + 8 * fq;
        float* ss = (u.pn == 0) ? sskv : ((u.pn >= 8) ? ssq : nullptr);
        const int nbj = (u.pn == 9) ? 1 : 2;
#pragma unroll
        for (int ai = 0; ai < 2; ++ai)
#pragma unroll
            for (int m = 0; m < 4; ++m) { const int row = row0 + ai * HALF + m * 16; bf16_t* rowp = Zp + (size_t)row * NZ + col0; float s = 0.f;
#pragma unroll
                for (int bj = 0; bj < 2; ++bj) { const f32x4 v0 = acc[ai][bj][m][0], v1 = acc[ai][bj][m][1];
                    u32x4 w; w.x = cvt_pk_bf16(v0[0], v0[1]); w.y = cvt_pk_bf16(v0[2], v0[3]); w.z = cvt_pk_bf16(v1[0], v1[1]); w.w = cvt_pk_bf16(v1[2], v1[3]);
                    *(u32x4*)(rowp + bj * HALF) = w;
                    if (bj < nbj) s += (v0[0] * v0[0] + v0[1] * v0[1]) + (v0[2] * v0[2] + v0[3] * v0[3]) + (v1[0] * v1[0] + v1[1] * v1[1]) + (v1[2] * v1[2] + v1[3] * v1[3]); }
                if (ss) { s += __shfl_xor(s, 16); s += __shfl_xor(s, 32); if (fq == 0) unsafeAtomicAdd(ss + row, s); } }
    }
};
struct EpiQ {
    static constexpr bool PERM = false, AFTER_DRAIN = false;
    bf16_t* Qp; const float* ssq; const float* cs;
    __device__ __forceinline__ void operator()(const f32x4 (&acc)[2][2][4][2], const Unit& u, int wr, int wc, int fr, int fq) const {
        const int row0 = u.pm * BM + wr * 64 + fr;
#pragma unroll
        for (int ai = 0; ai < 2; ++ai)
#pragma unroll
            for (int m = 0; m < 4; ++m) { const int row = row0 + ai * HALF + m * 16; const float rs = rsqrtf(ssq[row] * (1.0f / QLORA) + EPSN) * C2Q;
#pragma unroll
                for (int bj = 0; bj < 2; ++bj) { const int cgp = u.pn * BM + bj * HALF + wc * 32; const bool rope = ((cgp >> 5) % 3) == 2;
                    f32x4 v0 = acc[ai][bj][m][0] * rs, v1 = acc[ai][bj][m][1] * rs;
                    if (rope) { const f32x4* csp = (const f32x4*)(cs + ((size_t)row * 16 + 4 * fq) * 2); const f32x4 c01 = csp[0], c23 = csp[1];
                        const f32x4 t1 = v0, t2 = v1;
                        v0[0] = t1[0] * c01[0] - t2[0] * c01[1]; v1[0] = t2[0] * c01[0] + t1[0] * c01[1];
                        v0[1] = t1[1] * c01[2] - t2[1] * c01[3]; v1[1] = t2[1] * c01[2] + t1[1] * c01[3];
                        v0[2] = t1[2] * c23[0] - t2[2] * c23[1]; v1[2] = t2[2] * c23[0] + t1[2] * c23[1];
                        v0[3] = t1[3] * c23[2] - t2[3] * c23[3]; v1[3] = t2[3] * c23[2] + t1[3] * c23[3]; }
                    bf16_t* p = Qp + (size_t)row * NQ + cgp + 4 * fq;
                    u32x2 a; a.x = cvt_pk_bf16(v0[0], v0[1]); a.y = cvt_pk_bf16(v0[2], v0[3]); *(u32x2*)p = a;
                    u32x2 b; b.x = cvt_pk_bf16(v1[0], v1[1]); b.y = cvt_pk_bf16(v1[2], v1[3]); *(u32x2*)(p + 16) = b; } }
    }
};
struct EpiKV {
    static constexpr bool PERM = true, AFTER_DRAIN = false;
    bf16_t* KVp; const float* sskv;
    __device__ __forceinline__ void operator()(const f32x4 (&acc)[2][2][4][2], const Unit& u, int wr, int wc, int fr, int fq) const {
        const int row0 = u.pm * BM + wr * 64 + fr, col0 = u.pn * BM + wc * 32 + 8 * fq;
#pragma unroll
        for (int ai = 0; ai < 2; ++ai)
#pragma unroll
            for (int m = 0; m < 4; ++m) { const int row = row0 + ai * HALF + m * 16; const float rs = rsqrtf(sskv[row] * (1.0f / KVLORA) + EPSN); bf16_t* rowp = KVp + (size_t)row * NKV + col0;
#pragma unroll
                for (int bj = 0; bj < 2; ++bj) { const f32x4 v0 = acc[ai][bj][m][0] * rs, v1 = acc[ai][bj][m][1] * rs;
                    u32x4 w; w.x = cvt_pk_bf16(v0[0], v0[1]); w.y = cvt_pk_bf16(v0[2], v0[3]); w.z = cvt_pk_bf16(v1[0], v1[1]); w.w = cvt_pk_bf16(v1[2], v1[3]);
                    *(u32x4*)(rowp + bj * HALF) = w; } }
    }
};
struct EpiOut {
    static constexpr bool PERM = false, AFTER_DRAIN = false;
    const float* x; float* out; const float* mod; float* rowss;
    __device__ __forceinline__ void operator()(const f32x4 (&acc)[2][2][4][2], const Unit& u, int wr, int wc, int fr, int fq) const {
        const int row0 = u.pm * BM + wr * 64 + fr; const float* gb = mod + (size_t)((u.pm * BM) / SEQ) * (3 * DM) + 2 * DM;
        const int col0 = u.pn * BM + wc * 32 + 4 * fq;
        f32x4 gv[2][2];
#pragma unroll
        for (int bj = 0; bj < 2; ++bj)
#pragma unroll
            for (int n = 0; n < 2; ++n) gv[bj][n] = *(const f32x4*)(gb + col0 + bj * HALF + n * 16);
#pragma unroll
        for (int ai = 0; ai < 2; ++ai)
#pragma unroll
            for (int m = 0; m < 4; ++m) { const int row = row0 + ai * HALF + m * 16; const size_t off = (size_t)row * DM + col0; float s = 0.f;
#pragma unroll
                for (int bj = 0; bj < 2; ++bj)
#pragma unroll
                    for (int n = 0; n < 2; ++n) { const f32x4 xv = *(const f32x4*)(x + off + bj * HALF + n * 16); const f32x4 o = xv + gv[bj][n] * acc[ai][bj][m][n];
                        *(f32x4*)(out + off + bj * HALF + n * 16) = o; s += (o[0] * o[0] + o[1] * o[1]) + (o[2] * o[2] + o[3] * o[3]); }
                s += __shfl_xor(s, 16); s += __shfl_xor(s, 32); if (fq == 0) unsafeAtomicAdd(rowss + row, s); }
    }
};
}
#define MFMA32(a, b, c) __builtin_amdgcn_mfma_f32_32x32x16_bf16((a), (b), (c), 0, 0, 0)
typedef short v4i16_t __attribute__((ext_vector_type(4)));
__device__ __forceinline__ s16x4 vtr(const LAS unsigned char* p) { return __builtin_bit_cast(s16x4, __builtin_amdgcn_ds_read_tr16_b64_v4i16((LAS v4i16_t*)p)); }
__device__ __forceinline__ int crow(int i, int h) { return (i & 3) + 8 * (i >> 2) + 4 * h; }

template <int VP>
__device__ __forceinline__ void softmax_pv(f32x16& p0, f32x16& p1, f32x16& o0, f32x16& o1, float& m, float& l, const LAS unsigned char* vb) {
    float mx = fmaxf(p0[0], p1[0]);
#pragma unroll
    for (int i = 1; i < 16; ++i) mx = fmaxf(mx, fmaxf(p0[i], p1[i]));
    mx = fmaxf(mx, __shfl_xor(mx, 32));
    const float mn = fmaxf(m, mx), alpha = __builtin_amdgcn_exp2f(m - mn); m = mn;
    float rs = 0.f;
#pragma unroll
    for (int i = 0; i < 16; ++i) { p0[i] = __builtin_amdgcn_exp2f(p0[i] - mn); p1[i] = __builtin_amdgcn_exp2f(p1[i] - mn); rs += p0[i] + p1[i]; }
    l = l * alpha + rs;
#pragma unroll
    for (int i = 0; i < 16; ++i) { o0[i] *= alpha; o1[i] *= alpha; }
    u32x4 w[4];
#pragma unroll
    for (int q = 0; q < 4; ++q) { w[0][q] = pk_bf16(p0[2 * q], p0[2 * q + 1]); w[1][q] = pk_bf16(p0[8 + 2 * q], p0[9 + 2 * q]); w[2][q] = pk_bf16(p1[2 * q], p1[2 * q + 1]); w[3][q] = pk_bf16(p1[8 + 2 * q], p1[9 + 2 * q]); }
#pragma unroll
    for (int ks = 0; ks < 4; ++ks) {
        const bf16x8 pf = __builtin_bit_cast(bf16x8, w[ks]);
        { const s16x4 lo = vtr(vb + ks * 16 * VP), hh = vtr(vb + (ks * 16 + 8) * VP);
          const bf16x8 vf = {lo[0], lo[1], lo[2], lo[3], hh[0], hh[1], hh[2], hh[3]}; o0 = MFMA32(vf, pf, o0); }
        { const s16x4 lo = vtr(vb + ks * 16 * VP + 64), hh = vtr(vb + (ks * 16 + 8) * VP + 64);
          const bf16x8 vf = {lo[0], lo[1], lo[2], lo[3], hh[0], hh[1], hh[2], hh[3]}; o1 = MFMA32(vf, pf, o1); }
    }
}
__device__ __forceinline__ void attn_store(const f32x16& o0, const f32x16& o1, float inv, const bf16* gp, bf16* yp, int hi) {
#pragma unroll
    for (int dt = 0; dt < 2; ++dt)
#pragma unroll
        for (int g4 = 0; g4 < 4; ++g4) { const int d = 32 * dt + 8 * g4 + 4 * hi; const u32x2 gg = *(const u32x2*)(gp + d);
            const f32x16& o = dt ? o1 : o0;
            const float a0 = o[4 * g4] * inv * silu_f(bf_lo(gg.x)), a1 = o[4 * g4 + 1] * inv * silu_f(bf_hi(gg.x)), a2 = o[4 * g4 + 2] * inv * silu_f(bf_lo(gg.y)), a3 = o[4 * g4 + 3] * inv * silu_f(bf_hi(gg.y));
            u32x2 w; w.x = pk_bf16(a0, a1); w.y = pk_bf16(a2, a3); *(u32x2*)(yp + d) = w; }
}

constexpr int MLA_KP = 208, MLA_VP = 144, MLA_KST = 64 * MLA_KP, MLA_VST = 64 * MLA_VP, MLA_KOFF = 0, MLA_VOFF = 2 * MLA_KST;
__device__ __forceinline__ void mla_unit(int b, int h, int qb, const bf16* Q, const bf16* KV, const bf16* KPE, const bf16* Z, bf16* Y, LAS unsigned char* lds, int wid) {
    const int lane = lane_id_v(), tid = wid * 64 + lane, r32 = lane & 31, hi = lane >> 5;
    const size_t row0 = (size_t)b * SEQ;
    const int q0 = qb * 256, qw0 = q0 + wid * 32, qrow = qw0 + r32;
    bf16x8 qr[6];
    { const bf16* qp = Q + (row0 + qrow) * NQ + h * 96 + hi * 8;
#pragma unroll
      for (int ks = 0; ks < 6; ++ks) qr[ks] = *(const bf16x8*)(qp + ks * 16); }
    f32x16 o0, o1;
#pragma unroll
    for (int i = 0; i < 16; ++i) { o0[i] = 0.f; o1[i] = 0.f; }
    float m = -1e30f, l = 0.f;
    const int NT = 4 * (qb + 1);
    const int srow = tid >> 3, sch = tid & 7, prow = (tid >> 2) & 63, pch = tid & 3;
    const bf16* kg = KV + (row0 + srow) * NKV + h * 128 + sch * 8;
    const bf16* pg = KPE + (row0 + prow) * 32 + pch * 8;
    const unsigned kwoff = srow * MLA_KP + sch * 16, pwoff = prow * MLA_KP + 128 + pch * 16, vwoff = srow * MLA_VP + sch * 16;
    u32x4 kreg, vreg, preg = {0u, 0u, 0u, 0u};
#define MLA_LOAD(t) do { kreg = *(const u32x4*)(kg + (size_t)(t) * 64 * NKV); vreg = *(const u32x4*)(kg + (size_t)(t) * 64 * NKV + 64); if (wid < 4) preg = *(const u32x4*)(pg + (size_t)(t) * 64 * 32); } while (0)
#define MLA_STORE(st) do { *(LAS u32x4*)(lds + MLA_KOFF + (st) * MLA_KST + kwoff) = kreg; *(LAS u32x4*)(lds + MLA_VOFF + (st) * MLA_VST + vwoff) = vreg; if (wid < 4) *(LAS u32x4*)(lds + MLA_KOFF + (st) * MLA_KST + pwoff) = preg; } while (0)
    MLA_LOAD(0); MLA_STORE(0); __syncthreads();
    for (int t = 0; t < NT; ++t) {
        const int st = t & 1;
        if (t + 1 < NT) MLA_LOAD(t + 1);
        const int k0 = t * 64;
        if (k0 <= qw0 + 31) {
            const LAS unsigned char* kb = lds + MLA_KOFF + st * MLA_KST + r32 * MLA_KP + hi * 16;
            f32x16 p0, p1;
#pragma unroll
            for (int i = 0; i < 16; ++i) { p0[i] = 0.f; p1[i] = 0.f; }
#pragma unroll
            for (int ks = 0; ks < 6; ++ks) { const bf16x8 a0 = *(const LAS bf16x8*)(kb + ks * 32), a1 = *(const LAS bf16x8*)(kb + 32 * MLA_KP + ks * 32);
                p0 = MFMA32(a0, qr[ks], p0); p1 = MFMA32(a1, qr[ks], p1); }
            if (k0 + 63 > qw0) {
#pragma unroll
                for (int i = 0; i < 16; ++i) { const int key = k0 + crow(i, hi); if (key > qrow) p0[i] = -INFINITY; if (key + 32 > qrow) p1[i] = -INFINITY; }
            }
            const LAS unsigned char* vb = lds + MLA_VOFF + st * MLA_VST + (4 * hi + ((lane & 15) >> 2)) * MLA_VP + ((lane >> 4) & 1) * 32 + (lane & 3) * 8;
            softmax_pv<MLA_VP>(p0, p1, o0, o1, m, l, vb);
        }
        if (t + 1 < NT) MLA_STORE(st ^ 1);
        __syncthreads();
    }
#undef MLA_LOAD
#undef MLA_STORE
    l += __shfl_xor(l, 32);
    attn_store(o0, o1, 1.f / l, Z + (row0 + qrow) * NZ + GMLA_OFF + h * 64, Y + (row0 + qrow) * DM + h * 64, hi);
}

constexpr int SWA_P = 144, SWA_KOFF = 0, SWA_VOFF = 384 * SWA_P, SWA_POFF = 2 * 384 * SWA_P;
__device__ __forceinline__ void swa_unit(int b, int kvh, int qb, const bf16* Z, const int* pos, const float* sinks, bf16* Y, LAS unsigned char* lds, int wid) {
    const int lane = lane_id_v(), tid = wid * 64 + lane, r32 = lane & 31, hi = lane >> 5;
    const size_t row0 = (size_t)b * SEQ;
    const int q0 = qb * 256, kbase = q0 - 128;
    for (int c = tid; c < 384 * 8; c += 512) { const int j = c >> 3, ch = c & 7, s = kbase + j; u32x4 kk = {0u, 0u, 0u, 0u}, vv = {0u, 0u, 0u, 0u};
        if (s >= 0) { const bf16* zp = Z + (row0 + s) * NZ + kvh * 64 + ch * 8; kk = *(const u32x4*)(zp + KS_OFF); vv = *(const u32x4*)(zp + VS_OFF); }
        *(LAS u32x4*)(lds + SWA_KOFF + j * SWA_P + ch * 16) = kk; *(LAS u32x4*)(lds + SWA_VOFF + j * SWA_P + ch * 16) = vv; }
    if (tid < 384) { const int s = kbase + tid; ((LAS float*)(lds + SWA_POFF))[tid] = s >= 0 ? (float)pos[row0 + s] : 0.f; }
    __syncthreads();
    const int qw0 = q0 + wid * 32, qrow = qw0 + r32;
    const float posq = (float)pos[row0 + qrow];
    const int tr0 = wid >> 1;
    const LAS float* posk = (const LAS float*)(lds + SWA_POFF);
    for (int g = 0; g < 4; ++g) {
        const int head = kvh * 4 + g;
        bf16x8 qr[4];
        { const bf16* qp = Z + (row0 + qrow) * NZ + QS_OFF + head * 64 + hi * 8;
#pragma unroll
          for (int ks = 0; ks < 4; ++ks) qr[ks] = *(const bf16x8*)(qp + ks * 16); }
        const float slope = __builtin_amdgcn_exp2f(-(float)(head + 1)) * LOG2E, sink_l2 = sinks[head] * LOG2E, cscale = 0.125f * LOG2E;
        f32x16 o0, o1;
#pragma unroll
        for (int i = 0; i < 16; ++i) { o0[i] = 0.f; o1[i] = 0.f; }
        float m = -1e30f, l = 0.f;
        for (int tt = 0; tt < 3; ++tt) {
            const int j0 = (tr0 + tt) * 64;
            if (kbase + j0 < 0) continue;
            const LAS unsigned char* kb = lds + SWA_KOFF + (j0 + r32) * SWA_P + hi * 16;
            f32x16 p0, p1;
#pragma unroll
            for (int i = 0; i < 16; ++i) { p0[i] = 0.f; p1[i] = 0.f; }
#pragma unroll
            for (int ks = 0; ks < 4; ++ks) { const bf16x8 a0 = *(const LAS bf16x8*)(kb + ks * 32), a1 = *(const LAS bf16x8*)(kb + 32 * SWA_P + ks * 32);
                p0 = MFMA32(a0, qr[ks], p0); p1 = MFMA32(a1, qr[ks], p1); }
#pragma unroll
            for (int g4 = 0; g4 < 4; ++g4) { const int jj = j0 + 8 * g4 + 4 * hi; const f32x4 pa = *(const LAS f32x4*)(posk + jj), pb = *(const LAS f32x4*)(posk + jj + 32);
#pragma unroll
                for (int e = 0; e < 4; ++e) { const int i = 4 * g4 + e; const int dist = qrow - (kbase + jj + e);
                    const float sa = p0[i] * cscale - slope * (posq - pa[e]), sb = p1[i] * cscale - slope * (posq - pb[e]);
                    p0[i] = ((unsigned)dist < 128u) ? sa : -INFINITY; p1[i] = ((unsigned)(dist - 32) < 128u) ? sb : -INFINITY; } }
            const LAS unsigned char* vb = lds + SWA_VOFF + (j0 + 4 * hi + ((lane & 15) >> 2)) * SWA_P + ((lane >> 4) & 1) * 32 + (lane & 3) * 8;
            softmax_pv<SWA_P>(p0, p1, o0, o1, m, l, vb);
        }
        l += __shfl_xor(l, 32); l += __builtin_amdgcn_exp2f(sink_l2 - m);
        attn_store(o0, o1, 1.f / l, Z + (row0 + qrow) * NZ + GSWA_OFF + head * 64, Y + (row0 + qrow) * DM + 512 + head * 64, hi);
    }
    __syncthreads();
}
__device__ __forceinline__ unsigned f2bf(float f) { unsigned u = __builtin_bit_cast(unsigned, f); return (u + 0x7fffu + ((u >> 16) & 1u)) >> 16; }
__device__ __forceinline__ unsigned pk2(float lo, float hi) { return f2bf(lo) | (f2bf(hi) << 16); }
__device__ __forceinline__ void transpose_item(const float* W, int K, int N, int src_col0, const float* kscale, bf16* WT, int dst_row0, int k0, LAS float* scr, int lane) {
    if (src_col0 >= 0) {
#pragma unroll 8
        for (int i = 0; i < 32; ++i) { const int kk = 2 * i + (lane >> 5); float v = W[(size_t)(k0 + kk) * N + src_col0 + (lane & 31)]; if (kscale) v *= kscale[k0 + kk]; scr[kk * 33 + (lane & 31)] = v; }
    } else {
#pragma unroll 8
        for (int i = 0; i < 32; ++i) { const int kk = 2 * i + (lane >> 5); scr[kk * 33 + (lane & 31)] = 0.f; }
    }
    LDS_WAIT(); asm volatile("" ::: "memory");
    const int c = lane & 7;
#pragma unroll
    for (int j = 0; j < 4; ++j) { const int n = (lane >> 3) + 8 * j; const LAS float* s = scr + (8 * c) * 33 + n;
        u32x4 o; o.x = pk2(s[0 * 33], s[1 * 33]); o.y = pk2(s[2 * 33], s[3 * 33]); o.z = pk2(s[4 * 33], s[5 * 33]); o.w = pk2(s[6 * 33], s[7 * 33]);
        *(u32x4*)(WT + (size_t)(dst_row0 + n) * K + k0 + 8 * c) = o; }
    LDS_WAIT(); asm volatile("" ::: "memory");
}
__device__ __forceinline__ int zcol_to_src(int n) {
    if (n < 256) return 384 + n;
    if (n < 768) return 672 + (n - 256);
    if (n < 1280) return 1184 + (n - 768);
    if (n < 1408) return 1696 + (n - 1280);
    if (n < 1536) return 1824 + (n - 1408);
    if (n < 2048) return 1952 + (n - 1536);
    if (n < 2432) return n - 2048;
    if (n < 2464) return 640 + (n - 2432);
    return -1;
}

struct Args { const float* x; const float* c; const int* pos; const float* w_ada; const float* b_ada; const float* norm_gain; const float* w_in; const float* q_gain; const float* kv_gain;
              const float* w_uq; const float* w_ukv; const float* sinks; const float* w_out; const float* final_gain; float* out; unsigned char* ws; int ph_lo, ph_hi, coop, pad; };

constexpr int NPHASE = 7;
__global__ void __launch_bounds__(512) fwd_kernel(Args a) {
    extern __shared__ __attribute__((aligned(16))) unsigned char lds_raw[];
    LAS unsigned char* lds = (LAS unsigned char*)lds_raw;
    cg::grid_group grid = cg::this_grid();
    const int wave = __builtin_amdgcn_readfirstlane(threadIdx.x >> 6);
#define PH_IDS() const int lane = lane_id_v(), tid = wave * 64 + lane; (void)tid; (void)lane
    const int G = gridDim.x, bx = blockIdx.x;
    unsigned char* ws = a.ws;
    bf16* WT_in = (bf16*)(ws + WS_WIN); bf16* WT_uq = (bf16*)(ws + WS_WUQ); bf16* WT_ukv = (bf16*)(ws + WS_WUKV); bf16* WT_out = (bf16*)(ws + WS_WOUT);
    float* MOD = (float*)(ws + WS_MOD); float* SSQ = (float*)(ws + WS_SSQ); float* SSKV = (float*)(ws + WS_SSKV); float* ROWSS = (float*)(ws + WS_ROWSS);
    float* CS = (float*)(ws + WS_CS); bf16* KPE = (bf16*)(ws + WS_KPE); bf16* H = (bf16*)(ws + WS_H); bf16* Y = (bf16*)(ws + WS_Y); bf16* Z = (bf16*)(ws + WS_Z);
    bf16* Q = (bf16*)(ws + WS_Q); bf16* KV = (bf16*)(ws + WS_KV);
    const int lo = a.ph_lo, hi_ph = a.ph_hi;
#define IN(k) (lo <= (k) && (k) < hi_ph)
#define SEAM(k) do { if (IN(k) && IN((k) + 1)) grid.sync(); } while (0)

    if (IN(0)) { PH_IDS();
        LAS float* scr = (LAS float*)(lds + wave * 16384);
        const bool split = G > 96;
        if (!split || bx < 48) {
            for (int u = bx; u < 48; u += (split ? 48 : G)) {
                const int n0 = 64 * u, k0 = 128 * wave;
                for (int idx = lane; idx < 4096; idx += 64) { const float cv = a.c[(idx >> 7) * DM + k0 + (idx & 127)]; scr[idx] = silu_f(cv); }
                LDS_WAIT(); asm volatile("" ::: "memory");
                float acc[32];
#pragma unroll
                for (int b = 0; b < 32; ++b) acc[b] = 0.f;
                for (int k4 = 0; k4 < 32; ++k4) {
                    const float* wp = a.w_ada + (size_t)(k0 + 4 * k4) * (3 * DM) + n0 + lane;
                    const float w0 = wp[0], w1 = wp[3 * DM], w2 = wp[6 * DM], w3 = wp[9 * DM];
#pragma unroll
                    for (int b = 0; b < 32; ++b) { const f32x4 s = *(const LAS f32x4*)(scr + b * 128 + 4 * k4); acc[b] += (s[0] * w0 + s[1] * w1) + (s[2] * w2 + s[3] * w3); }
                }
                __syncthreads();
#pragma unroll
                for (int b = 0; b < 32; ++b) scr[b * 64 + lane] = acc[b];
                __syncthreads();
                for (int o = tid; o < 2048; o += 512) { const int b = o >> 6, n = o & 63; float s = a.b_ada[n0 + n];
#pragma unroll
                    for (int w = 0; w < 8; ++w) s += ((const LAS float*)(lds + w * 16384))[b * 64 + n];
                    MOD[(size_t)b * (3 * DM) + n0 + n] = s; }
                __syncthreads();
            }
        }
        if (!split || bx >= 48) {
            const int nb = split ? G - 48 : G, bb = split ? bx - 48 : bx;
            const int tw = bb * 8 + wave, NTW = nb * 8;
            constexpr int I_IN = 16 * 80, I_UQ = 6 * 24, I_UKV = 4 * 32, I_OUT = 16 * 32;
            for (int it = tw; it < I_IN + I_UQ + I_UKV + I_OUT; it += NTW) {
                int r = it;
                if (r < I_IN) { const int kb = r / 80, nbk = r % 80; transpose_item(a.w_in, DM, NZ_USED, zcol_to_src(32 * nbk), nullptr, WT_in, 32 * nbk, 64 * kb, scr, lane); continue; } r -= I_IN;
                if (r < I_UQ) { const int kb = r / 24, nbk = r % 24; transpose_item(a.w_uq, QLORA, NQ, 32 * nbk, a.q_gain, WT_uq, 32 * nbk, 64 * kb, scr, lane); continue; } r -= I_UQ;
                if (r < I_UKV) { const int kb = r / 32, nbk = r % 32; transpose_item(a.w_ukv, KVLORA, NKV, 32 * nbk, a.kv_gain, WT_ukv, 32 * nbk, 64 * kb, scr, lane); continue; } r -= I_UKV;
                { const int kb = r / 32, nbk = r % 32; transpose_item(a.w_out, DM, DM, 32 * nbk, nullptr, WT_out, 32 * nbk, 64 * kb, scr, lane); }
            }
            const int gt = bb * 512 + tid, NGT = nb * 512;
            for (int idx = gt; idx < MTOK * 16; idx += NGT) { const int mrow = idx >> 4, i = idx & 15;
                const double inv = exp2(-(double)i * (13.287712379549449 / 16.0));
                const double ang = (double)a.pos[mrow] * inv; const double kq = rint(ang * 0.15915494309189535); const float rf = (float)(ang - kq * 6.283185307179586);
                CS[2 * (size_t)idx] = cosf(rf); CS[2 * (size_t)idx + 1] = sinf(rf); }
            for (int idx = gt; idx < 3 * MTOK / 4; idx += NGT) ((f32x4*)SSQ)[idx] = (f32x4){0.f, 0.f, 0.f, 0.f};
        }
    }
    SEAM(0);
    if (IN(1)) { PH_IDS();
        const int gw = bx * 8 + wave, NGW = G * 8;
        for (int ch = gw; ch < MTOK / 32; ch += NGW) {
            const int r0 = ch * 32, b = r0 / SEQ; const float* mb = MOD + (size_t)b * (3 * DM);
            f32x4 g1[4], sh[4];
#pragma unroll
            for (int j = 0; j < 4; ++j) { const int col = 4 * lane + 256 * j; const f32x4 gn = *(const f32x4*)(a.norm_gain + col), sc = *(const f32x4*)(mb + DM + col); sh[j] = *(const f32x4*)(mb + col); g1[j] = gn * (sc + 1.0f); }
            for (int r = 0; r < 32; ++r) {
                const f32x4* xr = (const f32x4*)(a.x + (size_t)(r0 + r) * DM) + lane;
                f32x4 v[4]; float s = 0.f;
#pragma unroll
                for (int j = 0; j < 4; ++j) { v[j] = xr[64 * j]; s += (v[j][0] * v[j][0] + v[j][1] * v[j][1]) + (v[j][2] * v[j][2] + v[j][3] * v[j][3]); }
                const float rstd = rsqrtf(wave_sum(s) * (1.0f / DM) + EPSN);
                u32x2* op = (u32x2*)(H + (size_t)(r0 + r) * DM) + lane;
#pragma unroll
                for (int j = 0; j < 4; ++j) { const f32x4 o = v[j] * rstd * g1[j] + sh[j]; u32x2 w; w.x = pk_bf16(o[0], o[1]); w.y = pk_bf16(o[2], o[3]); op[64 * j] = w; }
            }
        }
    }
    SEAM(1);
    if (IN(2)) {
        pg8::Gemm g{H, WT_in, MTOK, NZ, DM, DM}; pg8::StaticOrder S; S.init(MTOK, NZ, G, bx);
        pg8::EpiZ E{Z, SSQ, SSKV};
        pg8::gemm_phase<pg8::EpiZ, pg8::StaticOrder, true, true>(lds, g, S, E, wave);
    }
    SEAM(2);
    if (IN(3)) {
        { pg8::Gemm g{Z + ZQ_OFF, WT_uq, MTOK, NQ, QLORA, NZ}; pg8::StaticOrder S; S.init(MTOK, NQ, G, bx);
          pg8::EpiQ E{Q, SSQ, CS};
          pg8::gemm_phase<pg8::EpiQ, pg8::StaticOrder, true, true>(lds, g, S, E, wave); }
        { pg8::Gemm g{Z + ZKV_OFF, WT_ukv, MTOK, NKV, KVLORA, NZ}; pg8::StaticOrder S; S.init(MTOK, NKV, G, bx);
          pg8::EpiKV E{KV, SSKV};
          pg8::gemm_phase<pg8::EpiKV, pg8::StaticOrder, true, true>(lds, g, S, E, wave); }
        PH_IDS();
        for (int idx = bx * 512 + tid; idx < MTOK * 16; idx += G * 512) { const int mrow = idx >> 4, i = idx & 15;
            const bf16* zp = Z + (size_t)mrow * NZ + KR_OFF; const float t1 = __uint_as_float((unsigned)zp[i] << 16), t2 = __uint_as_float((unsigned)zp[16 + i] << 16);
            const float cc = CS[2 * (size_t)idx], sn = CS[2 * (size_t)idx + 1];
            KPE[(size_t)mrow * 32 + i] = (bf16)f2bf(t1 * cc - t2 * sn); KPE[(size_t)mrow * 32 + 16 + i] = (bf16)f2bf(t2 * cc + t1 * sn); }
    }
    SEAM(3);
    if (IN(4)) {
        for (int u = bx; u < NB * 8 * 8; u += G) { const int bh = u % (NB * 8), qb = 7 - u / (NB * 8); mla_unit(bh >> 3, bh & 7, qb, Q, KV, KPE, Z, Y, lds, wave); }
        for (int u = bx; u < NB * 2 * 8; u += G) { swa_unit(u >> 4, (u >> 3) & 1, u & 7, Z, a.pos, a.sinks, Y, lds, wave); }
    }
    SEAM(4);
    if (IN(5)) {
        pg8::Gemm g{Y, WT_out, MTOK, DM, DM, DM}; pg8::StaticOrder S; S.init(MTOK, DM, G, bx);
        pg8::EpiOut E{a.x, a.out, MOD, ROWSS};
        pg8::gemm_phase<pg8::EpiOut, pg8::StaticOrder, true, true>(lds, g, S, E, wave);
    }
    SEAM(5);
    if (IN(6)) { PH_IDS();
        for (int idx = bx * 512 + tid; idx < MTOK * (DM / 4); idx += G * 512) { const int row = idx >> 8, c4 = idx & 255;
            const float rstd = rsqrtf(ROWSS[row] * (1.0f / DM) + EPSN); const f32x4 fg = ((const f32x4*)a.final_gain)[c4];
            f32x4* p = (f32x4*)a.out + idx; *p = *p * rstd * fg; }
    }
#undef IN
#undef SEAM
}

#ifndef MK_MULTI
#define MK_MULTI 0
#endif
extern "C" void kernel_launch(void* const* d_in, const int* in_sizes, int n_in, void* d_out, int out_size, void* d_ws, size_t ws_size, hipStream_t stream) {
    static int grid = 0;
    if (grid == 0) {
        if (n_in != 14 || in_sizes[0] != MTOK * DM || out_size != MTOK * DM || ws_size < WS_END) { fprintf(stderr, "kernel_launch: unexpected shapes (n_in %d in0 %d out %d ws %zu)\n", n_in, n_in > 0 ? in_sizes[0] : -1, out_size, ws_size); grid = -1; return; }
        int dev = 0, cus = 0, per_cu = 0;
        if (hipGetDevice(&dev) != hipSuccess || hipDeviceGetAttribute(&cus, hipDeviceAttributeMultiprocessorCount, dev) != hipSuccess) { grid = -1; return; }
        if (hipFuncSetAttribute((const void*)fwd_kernel, hipFuncAttributeMaxDynamicSharedMemorySize, LDS_BYTES) != hipSuccess) { fprintf(stderr, "kernel_launch: hipFuncSetAttribute failed\n"); grid = -1; return; }
        if (hipOccupancyMaxActiveBlocksPerMultiprocessor(&per_cu, (const void*)fwd_kernel, 512, LDS_BYTES) != hipSuccess || per_cu < 1) { fprintf(stderr, "kernel_launch: occupancy query says %d\n", per_cu); per_cu = 1; }
        (void)hipGetLastError();
        grid = cus * per_cu;
    }
    if (grid < 0) return;
    Args a{};
    a.x = (const float*)d_in[0]; a.c = (const float*)d_in[1]; a.pos = (const int*)d_in[2]; a.w_ada = (const float*)d_in[3]; a.b_ada = (const float*)d_in[4]; a.norm_gain = (const float*)d_in[5];
    a.w_in = (const float*)d_in[6]; a.q_gain = (const float*)d_in[7]; a.kv_gain = (const float*)d_in[8]; a.w_uq = (const float*)d_in[9]; a.w_ukv = (const float*)d_in[10]; a.sinks = (const float*)d_in[11];
    a.w_out = (const float*)d_in[12]; a.final_gain = (const float*)d_in[13]; a.out = (float*)d_out; a.ws = (unsigned char*)d_ws;
#if MK_MULTI
    for (int p = 0; p < NPHASE; ++p) { a.ph_lo = p; a.ph_hi = p + 1; a.coop = 0; hipLaunchKernelGGL(fwd_kernel, dim3(grid), dim3(512), LDS_BYTES, stream, a); }
#else
    a.ph_lo = 0; a.ph_hi = NPHASE; a.coop = 1;
    void* args[] = {&a};
    hipError_t e = hipLaunchCooperativeKernel((const void*)fwd_kernel, dim3(grid), dim3(512), args, LDS_BYTES, stream);
    if (e != hipSuccess) fprintf(stderr, "cooperative launch failed: %s (grid %d)\n", hipGetErrorString(e), grid);
#endif
}
```

```cpp
#include <hip/hip_runtime.h>
#include <hip/hip_cooperative_groups.h>
#include <cstdio>
#include <cstdint>
namespace cg = cooperative_groups;
__device__ __forceinline__ int lane_id_v() { int l; asm volatile("v_mbcnt_lo_u32_b32 %0, -1, 0\n\tv_mbcnt_hi_u32_b32 %0, -1, %0" : "=v"(l)); return l; }
namespace pg8 {
#define PG8_LAS __attribute__((address_space(3)))
typedef unsigned short bf16_t;
typedef short bf16x8 __attribute__((ext_vector_type(8)));
typedef float f32x4 __attribute__((ext_vector_type(4)));
typedef unsigned u32x4 __attribute__((ext_vector_type(4)));
constexpr int BM = 256, BK = 64, HALF = 128, HTB = HALF * BK * 2  , STAGE_BYTES = 8 * HTB, NXCD = 8, WGM = 8;

__host__ __device__ __forceinline__ int lds_byte(int r, int c) { const int st = (r >> 4) * 2 + (c >> 5), rr = r & 15, cc = c & 31, ob = rr * 64 + cc * 2; return st * 1024 + (ob ^ (((ob >> 9) & 1) << 5)); }
__host__ __device__ __forceinline__ void stage_rc(int b, int& R, int& C) { const int st = b / 1024, sb = b % 1024, swz = sb ^ (((sb >> 9) & 1) << 5); R = (st >> 1) * 16 + swz / 64; C = (st & 1) * 32 + (swz % 64) / 2; }
__host__ __device__ __forceinline__ int perm32(int rho) { const int n = rho >> 4, i = rho & 15; return 8 * (i >> 2) + 4 * n + (i & 3); }

struct Unit { int pm, pn; };
struct Gemm { const bf16_t* A; const bf16_t* Bt; int M, N, K, lda; };

struct StaticOrder {
    int nM, nN, nwg, G, c;
    __host__ __device__ void init(int M, int N, int G_, int c_) { nM = M / BM; nN = N / BM; nwg = nM * nN; G = G_; c = c_; }
    __host__ __device__ bool next(int i, Unit& u) const {
        const long L = (long)i * G + c; if (L >= nwg) return false;
        int wgid = (int)L; { const int q = nwg / NXCD, r = nwg % NXCD, xcd = wgid % NXCD, off = wgid / NXCD; wgid = (xcd < r ? xcd * (q + 1) : r * (q + 1) + (xcd - r) * q) + off; }
        const int nig = WGM * nN, gid = wgid / nig, fm = gid * WGM, gsz = (nM - fm) < WGM ? (nM - fm) : WGM;
        u.pm = fm + ((wgid % nig) % gsz); u.pn = (wgid % nig) / gsz; return true;
    }
    __device__ __forceinline__ void a_ready(const Unit&) const {}
    __device__ __forceinline__ void done(const Unit&) const {}
};

__device__ __forceinline__ unsigned cvt_pk_bf16(float lo, float hi) { unsigned r; asm volatile("v_cvt_pk_bf16_f32 %0, %1, %2" : "=v"(r) : "v"(lo), "v"(hi)); return r; }
typedef float f32x2 __attribute__((ext_vector_type(2)));
template <class Epi, class Sched, bool ALIGN_EPI = false, bool SP2 = false>
__device__ __forceinline__ void gemm_phase(PG8_LAS unsigned char* lds, const Gemm g, const Sched& S, const Epi& E, int wid_in) {
    const int wid = wid_in, lane = lane_id_v(), tid = wid * 64 + lane, wr = wid >> 2, wc = wid & 3, fr = lane & 15, fq = lane >> 4;
    int K_ = g.K; asm volatile("" : "+s"(K_));
    const int K = K_, nt = K / BK;
    unsigned voffA[2], voffB[2];
#pragma unroll
    for (int i = 0; i < 2; ++i) { int R, C; stage_rc(tid * 16 + i * 8192, R, C); const int Rb = Epi::PERM ? ((R & ~31) + perm32(R & 31)) : R;
        voffA[i] = (unsigned)(R * g.lda + C) * 2u; voffB[i] = (unsigned)(Rb * K + C) * 2u; }
    const size_t kstep = (size_t)(BK * 2);
    const size_t hstepB = (size_t)HALF * K * 2, hstepA = (size_t)HALF * g.lda * 2;
    const size_t tstepA = 2 * hstepA, tstepB = 2 * hstepB;
    const unsigned ldsw = (unsigned)wid * 1024u;
    const int aoff = lds_byte(wr * 64 + fr, fq * 8), boff = lds_byte(wc * 32 + fr, fq * 8);
#define PG8_SA(b, h) (((b) * 2 + (h)) * HTB)
#define PG8_SB(b, h) ((4 + (b) * 2 + (h)) * HTB)
#define PG8_STAGE(bufoff, gbase, voff) do { _Pragma("unroll") for (int _i = 0; _i < 2; ++_i) \
        __builtin_amdgcn_global_load_lds((const unsigned*)((const char*)(gbase) + (voff)[_i]), (PG8_LAS unsigned*)(lds + (bufoff) + ldsw + _i * 8192), 16, 0, 0); } while (0)
#define PG8_LDA(dst, b, h) do { _Pragma("unroll") for (int m = 0; m < 4; ++m) _Pragma("unroll") for (int k = 0; k < 2; ++k) dst[m][k] = *(const PG8_LAS bf16x8*)(lds + PG8_SA(b, h) + aoff + m * 2048 + k * 1024); } while (0)
#define PG8_LDB(dst, b, h) do { _Pragma("unroll") for (int n = 0; n < 2; ++n) _Pragma("unroll") for (int k = 0; k < 2; ++k) dst[n][k] = *(const PG8_LAS bf16x8*)(lds + PG8_SB(b, h) + boff + n * 2048 + k * 1024); } while (0)
#define PG8_MMA(ai, bj, At, Bt) do { __builtin_amdgcn_s_setprio(1); _Pragma("unroll") for (int m = 0; m < 4; ++m) _Pragma("unroll") for (int n = 0; n < 2; ++n) _Pragma("unroll") for (int k = 0; k < 2; ++k) \
        acc[ai][bj][m][n] = __builtin_amdgcn_mfma_f32_16x16x32_bf16(Bt[n][k], At[m][k], acc[ai][bj][m][n], 0, 0, 0); __builtin_amdgcn_s_setprio(0); } while (0)
#define PG8_WAIT_V(n) asm volatile("s_waitcnt vmcnt(" #n ")" ::: "memory")
#define PG8_WAIT_L(n) asm volatile("s_waitcnt lgkmcnt(" #n ")" ::: "memory")
#define PG8_BAR __builtin_amdgcn_s_barrier()
#define PG8_SCHED __builtin_amdgcn_sched_barrier(0)
    Unit cur, nxt; int ui = 0;
    if (!S.next(0, cur)) return;
    f32x4 acc[2][2][4][2];
#pragma unroll
    for (int a = 0; a < 2; ++a)
#pragma unroll
        for (int b = 0; b < 2; ++b)
#pragma unroll
            for (int m = 0; m < 4; ++m)
#pragma unroll
                for (int n = 0; n < 2; ++n) acc[a][b][m][n] = (f32x4){0.f, 0.f, 0.f, 0.f};
    bf16x8 At[4][2], B0[2][2], B1[2][2];
    const char* cA = (const char*)g.A + (size_t)cur.pm * tstepA; const char* cB = (const char*)g.Bt + (size_t)cur.pn * tstepB;
    S.a_ready(cur);
    if constexpr (SP2) {
        PG8_STAGE(PG8_SB(0, 0), cB, voffB); PG8_STAGE(PG8_SB(0, 1), cB + hstepB, voffB); PG8_STAGE(PG8_SA(0, 0), cA, voffA); PG8_STAGE(PG8_SA(0, 1), cA + hstepA, voffA);
        if (wr == 1) PG8_BAR;
        PG8_WAIT_V(2); PG8_BAR;
        PG8_STAGE(PG8_SB(1, 0), cB + kstep, voffB); PG8_STAGE(PG8_SA(1, 0), cA + kstep, voffA); PG8_STAGE(PG8_SB(1, 1), cB + hstepB + kstep, voffB);
        PG8_WAIT_V(6); PG8_BAR;
    } else {
        PG8_STAGE(PG8_SB(0, 0), cB, voffB); PG8_STAGE(PG8_SA(0, 0), cA, voffA); PG8_STAGE(PG8_SB(0, 1), cB + hstepB, voffB); PG8_STAGE(PG8_SA(0, 1), cA + hstepA, voffA);
        if (wr == 1) PG8_BAR;
        PG8_WAIT_V(4); PG8_BAR;
        PG8_STAGE(PG8_SB(1, 0), cB + kstep, voffB); PG8_STAGE(PG8_SA(1, 0), cA + kstep, voffA); PG8_STAGE(PG8_SB(1, 1), cB + hstepB + kstep, voffB);
        PG8_WAIT_V(6); PG8_BAR;
    }
    for (;;) {
        const bool has_next = S.next(ui + 1, nxt);
        const char* nA = has_next ? (const char*)g.A + (size_t)nxt.pm * tstepA : cA; const char* nB = has_next ? (const char*)g.Bt + (size_t)nxt.pn * tstepB : cB;
        _Pragma("nounroll") for (int t = 0; t < nt; t += 2) {
            const bool last = (t == nt - 2);
            const char* a1 = cA + (size_t)(t + 1) * kstep;
            const char* a2 = last ? nA : cA + (size_t)(t + 2) * kstep; const char* b2 = last ? nB : cB + (size_t)(t + 2) * kstep;
            const char* a3 = a2 + kstep; const char* b3 = b2 + kstep;
            if (last && has_next) S.a_ready(nxt);
            if constexpr (SP2) {
            PG8_LDB(B0, 0, 0); PG8_LDB(B1, 0, 1); PG8_SCHED; PG8_LDA(At, 0, 0); PG8_STAGE(PG8_SA(1, 1), a1 + hstepA, voffA);
            PG8_WAIT_V(8); PG8_WAIT_L(0); PG8_BAR; PG8_MMA(0, 0, At, B0); PG8_MMA(0, 1, At, B1); PG8_BAR; PG8_SCHED;
            PG8_LDA(At, 0, 1); PG8_STAGE(PG8_SB(0, 0), b2, voffB); PG8_STAGE(PG8_SB(0, 1), b2 + hstepB, voffB); PG8_STAGE(PG8_SA(0, 0), a2, voffA);
            PG8_WAIT_V(8); PG8_WAIT_L(0); PG8_BAR; PG8_MMA(1, 0, At, B0); PG8_MMA(1, 1, At, B1); PG8_BAR; PG8_SCHED;
            PG8_LDB(B0, 1, 0); PG8_LDB(B1, 1, 1); PG8_SCHED; PG8_LDA(At, 1, 0); PG8_STAGE(PG8_SA(0, 1), a2 + hstepA, voffA);
            PG8_WAIT_V(8); PG8_WAIT_L(0); PG8_BAR; PG8_MMA(0, 0, At, B0); PG8_MMA(0, 1, At, B1); PG8_BAR; PG8_SCHED;
            PG8_LDA(At, 1, 1); PG8_STAGE(PG8_SB(1, 0), b3, voffB); PG8_STAGE(PG8_SB(1, 1), b3 + hstepB, voffB); PG8_STAGE(PG8_SA(1, 0), a3, voffA);
            PG8_WAIT_V(8); PG8_WAIT_L(0); PG8_BAR; PG8_MMA(1, 0, At, B0); PG8_MMA(1, 1, At, B1); PG8_BAR; PG8_SCHED;
            } else {
            PG8_LDB(B0, 0, 0); PG8_SCHED; PG8_LDA(At, 0, 0); PG8_STAGE(PG8_SA(1, 1), a1 + hstepA, voffA);
            PG8_WAIT_L(8); PG8_BAR; PG8_WAIT_L(0); PG8_MMA(0, 0, At, B0); PG8_BAR; PG8_SCHED;
            PG8_LDB(B1, 0, 1); PG8_STAGE(PG8_SB(0, 0), b2, voffB);
            PG8_BAR; PG8_WAIT_L(0); PG8_MMA(0, 1, At, B1); PG8_BAR;
            PG8_LDA(At, 0, 1); PG8_STAGE(PG8_SA(0, 0), a2, voffA);
            PG8_BAR; PG8_WAIT_L(0); PG8_MMA(1, 0, At, B0); PG8_BAR; PG8_SCHED;
            PG8_STAGE(PG8_SB(0, 1), b2 + hstepB, voffB);
            PG8_WAIT_V(6); PG8_BAR; PG8_MMA(1, 1, At, B1); PG8_BAR;
            PG8_LDB(B0, 1, 0); PG8_SCHED; PG8_LDA(At, 1, 0); PG8_STAGE(PG8_SA(0, 1), a2 + hstepA, voffA);
            PG8_WAIT_L(8); PG8_BAR; PG8_WAIT_L(0); PG8_MMA(0, 0, At, B0); PG8_BAR; PG8_SCHED;
            PG8_LDB(B1, 1, 1); PG8_STAGE(PG8_SB(1, 0), b3, voffB);
            PG8_BAR; PG8_WAIT_L(0); PG8_MMA(0, 1, At, B1); PG8_BAR;
            PG8_LDA(At, 1, 1); PG8_STAGE(PG8_SA(1, 0), a3, voffA);
            PG8_BAR; PG8_WAIT_L(0); PG8_MMA(1, 0, At, B0); PG8_BAR; PG8_SCHED;
            PG8_STAGE(PG8_SB(1, 1), b3 + hstepB, voffB);
            PG8_WAIT_V(6); PG8_BAR; PG8_MMA(1, 1, At, B1); PG8_BAR;
            }
        }
        if constexpr (ALIGN_EPI) { if (wr == 0) PG8_BAR; }
        if constexpr (!Epi::AFTER_DRAIN) { E(acc, cur, wr, wc, fr, fq); S.done(cur); }
        if (!has_next) break;
#pragma unroll
        for (int a = 0; a < 2; ++a)
#pragma unroll
            for (int b = 0; b < 2; ++b)
#pragma unroll
                for (int m = 0; m < 4; ++m)
#pragma unroll
                    for (int n = 0; n < 2; ++n) acc[a][b][m][n] = (f32x4){0.f, 0.f, 0.f, 0.f};
        cur = nxt; cA = nA; cB = nB; ++ui;
        if constexpr (ALIGN_EPI) { if (wr == 1) PG8_BAR; }
    }
    PG8_WAIT_V(0);
    if constexpr (!ALIGN_EPI) { if (wr == 0) PG8_BAR; }
    PG8_BAR;
    if constexpr (Epi::AFTER_DRAIN) { E.fused(acc, cur, wr, wc, fr, fq, lds, wid, lane); S.done(cur); }
#undef PG8_SA
#undef PG8_SB
#undef PG8_STAGE
#undef PG8_LDA
#undef PG8_LDB
#undef PG8_MMA
#undef PG8_WAIT_V
#undef PG8_WAIT_L
#undef PG8_BAR
#undef PG8_SCHED
}
}
#define LAS __attribute__((address_space(3)))
typedef unsigned short bf16;
typedef short bf16x8 __attribute__((ext_vector_type(8)));
typedef short s16x4 __attribute__((ext_vector_type(4)));
typedef float f32x4 __attribute__((ext_vector_type(4)));
typedef float f32x16 __attribute__((ext_vector_type(16)));
typedef unsigned u32x4 __attribute__((ext_vector_type(4)));
typedef unsigned u32x2 __attribute__((ext_vector_type(2)));

constexpr int NB = 32, SEQ = 2048, DM = 1024, MTOK = NB * SEQ;
constexpr int NZ = 2560;
constexpr int ZKV_OFF = 0, GMLA_OFF = 256, QS_OFF = 768, KS_OFF = 1280, VS_OFF = 1408, GSWA_OFF = 1536, ZQ_OFF = 2048, KR_OFF = 2432, NZ_USED = 2464;
constexpr int NQ = 768, NKV = 1024, QLORA = 384, KVLORA = 256;
constexpr float EPSN = 1e-6f;
constexpr float LOG2E = 1.4426950408889634f;
constexpr float C2Q = 0.10206207261596577f * 1.4426950408889634f;

constexpr size_t MiB = 1u << 20;
constexpr size_t WS_WIN = 0, WS_WUQ = 6 * MiB, WS_WUKV = 7 * MiB, WS_WOUT = 8 * MiB, WS_MOD = 10 * MiB;
constexpr size_t WS_SSQ = 13 * MiB, WS_SSKV = WS_SSQ + 256 * 1024, WS_ROWSS = WS_SSKV + 256 * 1024;
constexpr size_t WS_CS = 16 * MiB, WS_KPE = 24 * MiB, WS_H = 32 * MiB, WS_Y = WS_H, WS_Z = 160 * MiB, WS_Q = 480 * MiB, WS_KV = 576 * MiB, WS_END = 704 * MiB;

constexpr int LDS_BYTES = 147456;

__device__ __forceinline__ unsigned pk_bf16(float lo, float hi) { typedef float f2_t __attribute__((ext_vector_type(2))); typedef __bf16 b2_t __attribute__((ext_vector_type(2)));
    f2_t v = {lo, hi}; b2_t b = __builtin_convertvector(v, b2_t); return __builtin_bit_cast(unsigned, b); }
__device__ __forceinline__ float bf_lo(unsigned u) { return __uint_as_float(u << 16); }
__device__ __forceinline__ float bf_hi(unsigned u) { return __uint_as_float(u & 0xffff0000u); }
__device__ __forceinline__ float silu_f(float g) { return g * __builtin_amdgcn_rcpf(1.f + __builtin_amdgcn_exp2f(-g * LOG2E)); }
__device__ __forceinline__ float wave_sum(float v) {
#pragma unroll
    for (int o = 1; o < 64; o <<= 1) v += __shfl_xor(v, o);
    return v;
}
#define LDS_WAIT() asm volatile("s_waitcnt lgkmcnt(0)" ::: "memory")

namespace pg8 {
struct EpiZ {
    static constexpr bool PERM = true, AFTER_DRAIN = false;
    bf16_t* Zp; float* ssq; float* sskv;
    __device__ __forceinline__ void operator()(const f32x4 (&acc)[2][2][4][2], const Unit& u, int wr, int wc, int fr, int fq) const {
        const int row0 = u.pm * BM + wr * 64 + fr, col0 = u.pn * BM + wc * 32 + 8 * fq;
        float* ss = (u.pn == 0) ? sskv : ((u.pn >= 8) ? ssq : nullptr);
        const int nbj = (u.pn == 9) ? 1 : 2;
#pragma unroll
        for (int ai = 0; ai < 2; ++ai)
#pragma unroll
            for (int m = 0; m < 4; ++m) { const int row = row0 + ai * HALF + m * 16; bf16_t* rowp = Zp + (size_t)row * NZ + col0; float s = 0.f;
#pragma unroll
                for (int bj = 0; bj < 2; ++bj) { const f32x4 v0 = acc[ai][bj][m][0], v1 = acc[ai][bj][m][1];
                    u32x4 w; w.x = cvt_pk_bf16(v0[0], v0[1]); w.y = cvt_pk_bf16(v0[2], v0[3]); w.z = cvt_pk_bf16(v1[0], v1[1]); w.w = cvt_pk_bf16(v1[2], v1[3]);
                    *(u32x4*)(rowp + bj * HALF) = w;
                    if (bj < nbj) s += (v0[0] * v0[0] + v0[1] * v0[1]) + (v0[2] * v0[2] + v0[3] * v0[3]) + (v1[0] * v1[0] + v1[1] * v1[1]) + (v1[2] * v1[2] + v1[3] * v1[3]); }
                if (ss) { s += __shfl_xor(s, 16); s += __shfl_xor(s, 32); if (fq == 0) unsafeAtomicAdd(ss + row, s); } }
    }
};
struct EpiQ {
    static constexpr bool PERM = false, AFTER_DRAIN = false;
    bf16_t* Qp; const float* ssq; const float* cs;
    __device__ __forceinline__ void operator()(const f32x4 (&acc)[2][2][4][2], const Unit& u, int wr, int wc, int fr, int fq) const {
        const int row0 = u.pm * BM + wr * 64 + fr;
#pragma unroll
        for (int ai = 0; ai < 2; ++ai)
#pragma unroll
            for (int m = 0; m < 4; ++m) { const int row = row0 + ai * HALF + m * 16; const float rs = rsqrtf(ssq[row] * (1.0f / QLORA) + EPSN) * C2Q;
#pragma unroll
                for (int bj = 0; bj < 2; ++bj) { const int cgp = u.pn * BM + bj * HALF + wc * 32; const bool rope = ((cgp >> 5) % 3) == 2;
                    f32x4 v0 = acc[ai][bj][m][0] * rs, v1 = acc[ai][bj][m][1] * rs;
                    if (rope) { const f32x4* csp = (const f32x4*)(cs + ((size_t)row * 16 + 4 * fq) * 2); const f32x4 c01 = csp[0], c23 = csp[1];
                        const f32x4 t1 = v0, t2 = v1;
                        v0[0] = t1[0] * c01[0] - t2[0] * c01[1]; v1[0] = t2[0] * c01[0] + t1[0] * c01[1];
                        v0[1] = t1[1] * c01[2] - t2[1] * c01[3]; v1[1] = t2[1] * c01[2] + t1[1] * c01[3];
                        v0[2] = t1[2] * c23[0] - t2[2] * c23[1]; v1[2] = t2[2] * c23[0] + t1[2] * c23[1];
                        v0[3] = t1[3] * c23[2] - t2[3] * c23[3]; v1[3] = t2[3] * c23[2] + t1[3] * c23[3]; }
                    bf16_t* p = Qp + (size_t)row * NQ + cgp + 4 * fq;
                    u32x2 a; a.x = cvt_pk_bf16(v0[0], v0[1]); a.y = cvt_pk_bf16(v0[2], v0[3]); *(u32x2*)p = a;
                    u32x2 b; b.x = cvt_pk_bf16(v1[0], v1[1]); b.y = cvt_pk_bf16(v1[2], v1[3]); *(u32x2*)(p + 16) = b; } }
    }
};
struct EpiKV {
    static constexpr bool PERM = true, AFTER_DRAIN = false;
    bf16_t* KVp; const float* sskv;
    __device__ __forceinline__ void operator()(const f32x4 (&acc)[2][2][4][2], const Unit& u, int wr, int wc, int fr, int fq) const {
        const int row0 = u.pm * BM + wr * 64 + fr, col0 = u.pn * BM + wc * 32 + 8 * fq;
#pragma unroll
        for (int ai = 0; ai < 2; ++ai)
#pragma unroll
            for (int m = 0; m < 4; ++m) { const int row = row0 + ai * HALF + m * 16; const float rs = rsqrtf(sskv[row] * (1.0f / KVLORA) + EPSN); bf16_t* rowp = KVp + (size_t)row * NKV + col0;
#pragma unroll
                for (int bj = 0; bj < 2; ++bj) { const f32x4 v0 = acc[ai][bj][m][0] * rs, v1 = acc[ai][bj][m][1] * rs;
                    u32x4 w; w.x = cvt_pk_bf16(v0[0], v0[1]); w.y = cvt_pk_bf16(v0[2], v0[3]); w.z = cvt_pk_bf16(v1[0], v1[1]); w.w = cvt_pk_bf16(v1[2], v1[3]);
                    *(u32x4*)(rowp + bj * HALF) = w; } }
    }
};
struct EpiOut {
    static constexpr bool PERM = false, AFTER_DRAIN = false;
    const float* x; float* out; const float* mod; float* rowss;
    __device__ __forceinline__ void operator()(const f32x4 (&acc)[2][2][4][2], const Unit& u, int wr, int wc, int fr, int fq) const {
        const int row0 = u.pm * BM + wr * 64 + fr; const float* gb = mod + (size_t)((u.pm * BM) / SEQ) * (3 * DM) + 2 * DM;
        const int col0 = u.pn * BM + wc * 32 + 4 * fq;
        f32x4 gv[2][2];
#pragma unroll
        for (int bj = 0; bj < 2; ++bj)
#pragma unroll
            for (int n = 0; n < 2; ++n) gv[bj][n] = *(const f32x4*)(gb + col0 + bj * HALF + n * 16);
#pragma unroll
        for (int ai = 0; ai < 2; ++ai)
#pragma unroll
            for (int m = 0; m < 4; ++m) { const int row = row0 + ai * HALF + m * 16; const size_t off = (size_t)row * DM + col0; float s = 0.f;
#pragma unroll
                for (int bj = 0; bj < 2; ++bj)
#pragma unroll
                    for (int n = 0; n < 2; ++n) { const f32x4 xv = *(const f32x4*)(x + off + bj * HALF + n * 16); const f32x4 o = xv + gv[bj][n] * acc[ai][bj][m][n];
                        *(f32x4*)(out + off + bj * HALF + n * 16) = o; s += (o[0] * o[0] + o[1] * o[1]) + (o[2] * o[2] + o[3] * o[3]); }
                if (rowss) { s += __shfl_xor(s, 16); s += __shfl_xor(s, 32); if (fq == 0) unsafeAtomicAdd(rowss + row, s); } }
    }
};
}
#define MFMA32(a, b, c) __builtin_amdgcn_mfma_f32_32x32x16_bf16((a), (b), (c), 0, 0, 0)
typedef short v4i16_t __attribute__((ext_vector_type(4)));
__device__ __forceinline__ s16x4 vtr(const LAS unsigned char* p) { return __builtin_bit_cast(s16x4, __builtin_amdgcn_ds_read_tr16_b64_v4i16((LAS v4i16_t*)p)); }
__device__ __forceinline__ int crow(int i, int h) { return (i & 3) + 8 * (i >> 2) + 4 * h; }

template <int VP>
__device__ __forceinline__ void softmax_pv(f32x16& p0, f32x16& p1, f32x16& o0, f32x16& o1, float& m, float& l, const LAS unsigned char* vb) {
    float mx = fmaxf(p0[0], p1[0]);
#pragma unroll
    for (int i = 1; i < 16; ++i) mx = fmaxf(mx, fmaxf(p0[i], p1[i]));
    mx = fmaxf(mx, __shfl_xor(mx, 32));
    const float mn = fmaxf(m, mx), alpha = __builtin_amdgcn_exp2f(m - mn); m = mn;
    float rs = 0.f;
#pragma unroll
    for (int i = 0; i < 16; ++i) { p0[i] = __builtin_amdgcn_exp2f(p0[i] - mn); p1[i] = __builtin_amdgcn_exp2f(p1[i] - mn); rs += p0[i] + p1[i]; }
    l = l * alpha + rs;
#pragma unroll
    for (int i = 0; i < 16; ++i) { o0[i] *= alpha; o1[i] *= alpha; }
    u32x4 w[4];
#pragma unroll
    for (int q = 0; q < 4; ++q) { w[0][q] = pk_bf16(p0[2 * q], p0[2 * q + 1]); w[1][q] = pk_bf16(p0[8 + 2 * q], p0[9 + 2 * q]); w[2][q] = pk_bf16(p1[2 * q], p1[2 * q + 1]); w[3][q] = pk_bf16(p1[8 + 2 * q], p1[9 + 2 * q]); }
#pragma unroll
    for (int ks = 0; ks < 4; ++ks) {
        const bf16x8 pf = __builtin_bit_cast(bf16x8, w[ks]);
        { const s16x4 lo = vtr(vb + ks * 16 * VP), hh = vtr(vb + (ks * 16 + 8) * VP);
          const bf16x8 vf = {lo[0], lo[1], lo[2], lo[3], hh[0], hh[1], hh[2], hh[3]}; o0 = MFMA32(vf, pf, o0); }
        { const s16x4 lo = vtr(vb + ks * 16 * VP + 64), hh = vtr(vb + (ks * 16 + 8) * VP + 64);
          const bf16x8 vf = {lo[0], lo[1], lo[2], lo[3], hh[0], hh[1], hh[2], hh[3]}; o1 = MFMA32(vf, pf, o1); }
    }
}
__device__ __forceinline__ void attn_store(const f32x16& o0, const f32x16& o1, float inv, const bf16* gp, bf16* yp, int hi) {
#pragma unroll
    for (int dt = 0; dt < 2; ++dt)
#pragma unroll
        for (int g4 = 0; g4 < 4; ++g4) { const int d = 32 * dt + 8 * g4 + 4 * hi; const u32x2 gg = *(const u32x2*)(gp + d);
            const f32x16& o = dt ? o1 : o0;
            const float a0 = o[4 * g4] * inv * silu_f(bf_lo(gg.x)), a1 = o[4 * g4 + 1] * inv * silu_f(bf_hi(gg.x)), a2 = o[4 * g4 + 2] * inv * silu_f(bf_lo(gg.y)), a3 = o[4 * g4 + 3] * inv * silu_f(bf_hi(gg.y));
            u32x2 w; w.x = pk_bf16(a0, a1); w.y = pk_bf16(a2, a3); *(u32x2*)(yp + d) = w; }
}

constexpr int MLA_KP = 208, MLA_VP = 144, MLA_KST = 64 * MLA_KP, MLA_VST = 64 * MLA_VP, MLA_KOFF = 0, MLA_VOFF = 2 * MLA_KST;
__device__ __forceinline__ void mla_unit(int b, int h, int qb, const bf16* Q, const bf16* KV, const bf16* KPE, const bf16* Z, bf16* Y, LAS unsigned char* lds, int wid) {
    const int lane = lane_id_v(), tid = wid * 64 + lane, r32 = lane & 31, hi = lane >> 5;
    const size_t row0 = (size_t)b * SEQ;
    const int q0 = qb * 256, qw0 = q0 + wid * 32, qrow = qw0 + r32;
    bf16x8 qr[6];
    { const bf16* qp = Q + (row0 + qrow) * NQ + h * 96 + hi * 8;
#pragma unroll
      for (int ks = 0; ks < 6; ++ks) qr[ks] = *(const bf16x8*)(qp + ks * 16); }
    f32x16 o0, o1;
#pragma unroll
    for (int i = 0; i < 16; ++i) { o0[i] = 0.f; o1[i] = 0.f; }
    float m = -1e30f, l = 0.f;
    const int NT = 4 * (qb + 1);
    const int srow = tid >> 3, sch = tid & 7, prow = (tid >> 2) & 63, pch = tid & 3;
    const bf16* kg = KV + (row0 + srow) * NKV + h * 128 + sch * 8;
    const bf16* pg = KPE + (row0 + prow) * 32 + pch * 8;
    const unsigned kwoff = srow * MLA_KP + sch * 16, pwoff = prow * MLA_KP + 128 + pch * 16, vwoff = srow * MLA_VP + sch * 16;
    u32x4 kreg, vreg, preg = {0u, 0u, 0u, 0u};
#define MLA_LOAD(t) do { kreg = *(const u32x4*)(kg + (size_t)(t) * 64 * NKV); vreg = *(const u32x4*)(kg + (size_t)(t) * 64 * NKV + 64); if (wid < 4) preg = *(const u32x4*)(pg + (size_t)(t) * 64 * 32); } while (0)
#define MLA_STORE(st) do { *(LAS u32x4*)(lds + MLA_KOFF + (st) * MLA_KST + kwoff) = kreg; *(LAS u32x4*)(lds + MLA_VOFF + (st) * MLA_VST + vwoff) = vreg; if (wid < 4) *(LAS u32x4*)(lds + MLA_KOFF + (st) * MLA_KST + pwoff) = preg; } while (0)
    MLA_LOAD(0); MLA_STORE(0); __syncthreads();
    for (int t = 0; t < NT; ++t) {
        const int st = t & 1;
        if (t + 1 < NT) MLA_LOAD(t + 1);
        const int k0 = t * 64;
        if (k0 <= qw0 + 31) {
            const LAS unsigned char* kb = lds + MLA_KOFF + st * MLA_KST + r32 * MLA_KP + hi * 16;
            f32x16 p0, p1;
#pragma unroll
            for (int i = 0; i < 16; ++i) { p0[i] = 0.f; p1[i] = 0.f; }
#pragma unroll
            for (int ks = 0; ks < 6; ++ks) { const bf16x8 a0 = *(const LAS bf16x8*)(kb + ks * 32), a1 = *(const LAS bf16x8*)(kb + 32 * MLA_KP + ks * 32);
                p0 = MFMA32(a0, qr[ks], p0); p1 = MFMA32(a1, qr[ks], p1); }
            if (k0 + 63 > qw0) {
#pragma unroll
                for (int i = 0; i < 16; ++i) { const int key = k0 + crow(i, hi); if (key > qrow) p0[i] = -INFINITY; if (key + 32 > qrow) p1[i] = -INFINITY; }
            }
            const LAS unsigned char* vb = lds + MLA_VOFF + st * MLA_VST + (4 * hi + ((lane & 15) >> 2)) * MLA_VP + ((lane >> 4) & 1) * 32 + (lane & 3) * 8;
            softmax_pv<MLA_VP>(p0, p1, o0, o1, m, l, vb);
        }
        if (t + 1 < NT) MLA_STORE(st ^ 1);
        __syncthreads();
    }
#undef MLA_LOAD
#undef MLA_STORE
    l += __shfl_xor(l, 32);
    attn_store(o0, o1, 1.f / l, Z + (row0 + qrow) * NZ + GMLA_OFF + h * 64, Y + (row0 + qrow) * DM + h * 64, hi);
}

constexpr int SWA_P = 144, SWA_KOFF = 0, SWA_VOFF = 384 * SWA_P, SWA_POFF = 2 * 384 * SWA_P;
__device__ __forceinline__ void swa_unit(int b, int kvh, int qb, const bf16* Z, const int* pos, const float* sinks, bf16* Y, LAS unsigned char* lds, int wid) {
    const int lane = lane_id_v(), tid = wid * 64 + lane, r32 = lane & 31, hi = lane >> 5;
    const size_t row0 = (size_t)b * SEQ;
    const int q0 = qb * 256, kbase = q0 - 128;
    for (int c = tid; c < 384 * 8; c += 512) { const int j = c >> 3, ch = c & 7, s = kbase + j; u32x4 kk = {0u, 0u, 0u, 0u}, vv = {0u, 0u, 0u, 0u};
        if (s >= 0) { const bf16* zp = Z + (row0 + s) * NZ + kvh * 64 + ch * 8; kk = *(const u32x4*)(zp + KS_OFF); vv = *(const u32x4*)(zp + VS_OFF); }
        *(LAS u32x4*)(lds + SWA_KOFF + j * SWA_P + ch * 16) = kk; *(LAS u32x4*)(lds + SWA_VOFF + j * SWA_P + ch * 16) = vv; }
    if (tid < 384) { const int s = kbase + tid; ((LAS float*)(lds + SWA_POFF))[tid] = s >= 0 ? (float)pos[row0 + s] : 0.f; }
    __syncthreads();
    const int qw0 = q0 + wid * 32, qrow = qw0 + r32;
    const float posq = (float)pos[row0 + qrow];
    const int tr0 = wid >> 1;
    const LAS float* posk = (const LAS float*)(lds + SWA_POFF);
    for (int g = 0; g < 4; ++g) {
        const int head = kvh * 4 + g;
        bf16x8 qr[4];
        { const bf16* qp = Z + (row0 + qrow) * NZ + QS_OFF + head * 64 + hi * 8;
#pragma unroll
          for (int ks = 0; ks < 4; ++ks) qr[ks] = *(const bf16x8*)(qp + ks * 16); }
        const float slope = __builtin_amdgcn_exp2f(-(float)(head + 1)) * LOG2E, sink_l2 = sinks[head] * LOG2E, cscale = 0.125f * LOG2E;
        f32x16 o0, o1;
#pragma unroll
        for (int i = 0; i < 16; ++i) { o0[i] = 0.f; o1[i] = 0.f; }
        float m = -1e30f, l = 0.f;
        for (int tt = 0; tt < 3; ++tt) {
            const int j0 = (tr0 + tt) * 64;
            if (kbase + j0 < 0) continue;
            const LAS unsigned char* kb = lds + SWA_KOFF + (j0 + r32) * SWA_P + hi * 16;
            f32x16 p0, p1;
#pragma unroll
            for (int i = 0; i < 16; ++i) { p0[i] = 0.f; p1[i] = 0.f; }
#pragma unroll
            for (int ks = 0; ks < 4; ++ks) { const bf16x8 a0 = *(const LAS bf16x8*)(kb + ks * 32), a1 = *(const LAS bf16x8*)(kb + 32 * SWA_P + ks * 32);
                p0 = MFMA32(a0, qr[ks], p0); p1 = MFMA32(a1, qr[ks], p1); }
#pragma unroll
            for (int g4 = 0; g4 < 4; ++g4) { const int jj = j0 + 8 * g4 + 4 * hi; const f32x4 pa = *(const LAS f32x4*)(posk + jj), pb = *(const LAS f32x4*)(posk + jj + 32);
#pragma unroll
                for (int e = 0; e < 4; ++e) { const int i = 4 * g4 + e; const int dist = qrow - (kbase + jj + e);
                    const float sa = p0[i] * cscale - slope * (posq - pa[e]), sb = p1[i] * cscale - slope * (posq - pb[e]);
                    p0[i] = ((unsigned)dist < 128u) ? sa : -INFINITY; p1[i] = ((unsigned)(dist - 32) < 128u) ? sb : -INFINITY; } }
            const LAS unsigned char* vb = lds + SWA_VOFF + (j0 + 4 * hi + ((lane & 15) >> 2)) * SWA_P + ((lane >> 4) & 1) * 32 + (lane & 3) * 8;
            softmax_pv<SWA_P>(p0, p1, o0, o1, m, l, vb);
        }
        l += __shfl_xor(l, 32); l += __builtin_amdgcn_exp2f(sink_l2 - m);
        attn_store(o0, o1, 1.f / l, Z + (row0 + qrow) * NZ + GSWA_OFF + head * 64, Y + (row0 + qrow) * DM + 512 + head * 64, hi);
    }
    __syncthreads();
}
#define XB_TMO      128
#define XB_XCNT(j)  (256  + 64 * (j))
#define XB_XSUB(j)  (1280 + 64 * (j))
#define XB_XGEN(j)  (2304 + 64 * (j))
#define XB_TOP      3328
#define XB_TOPGEN   3392
#define XCD_BAR_WORDS 3456
#define XB_SPIN_CAP (1u << 18)

__device__ __forceinline__ unsigned xb_ld(unsigned* p)              { return __hip_atomic_load(p, __ATOMIC_RELAXED, __HIP_MEMORY_SCOPE_AGENT); }
__device__ __forceinline__ unsigned xb_add(unsigned* p, unsigned v) { return __hip_atomic_fetch_add(p, v, __ATOMIC_RELAXED, __HIP_MEMORY_SCOPE_AGENT); }
__device__ __forceinline__ unsigned xb_xcc_id() { return (unsigned)__builtin_amdgcn_s_getreg((3 << 11) | 20) & 0xFu; }
#define XB_SPIN(cond, bar) do { unsigned _sp = 0; while (cond) { __builtin_amdgcn_s_sleep(1); \
    if ((++_sp & 255u) == 0u) { if (xb_ld(&(bar)[XB_TMO])) break; if (_sp > XB_SPIN_CAP) { atomicAdd(&(bar)[XB_TMO], 1u); break; } } } } while (0)

struct XcdBarrier {
    unsigned* bar; unsigned x;
    volatile LAS unsigned* st;
};

__device__ __forceinline__ XcdBarrier xcd_barrier_post(unsigned* bar, volatile LAS unsigned* st) {
    XcdBarrier b; b.bar = bar; b.x = xb_xcc_id(); b.st = st;
    if (threadIdx.x == 0) (void)xb_add(&bar[XB_XCNT(b.x)], 1u);
    return b;
}
__device__ __forceinline__ void xcd_barrier_complete(unsigned* bar, unsigned x, unsigned& nloc, unsigned& nx) {
    const unsigned G = gridDim.x * gridDim.y * gridDim.z;
    unsigned sum, cnt, mine, sp = 0u;
    for (;;) {
        sum = 0u; cnt = 0u; mine = 0u;
#pragma unroll
        for (unsigned j = 0; j < 16; ++j) { const unsigned c = xb_ld(&bar[XB_XCNT(j)]); sum += c; cnt += (c > 0u) ? 1u : 0u; mine = (j == x) ? c : mine; }
        if (sum == G) break;
        __builtin_amdgcn_s_sleep(1);
        if ((++sp & 255u) == 0u) { if (xb_ld(&bar[XB_TMO])) break; if (sp > XB_SPIN_CAP) { atomicAdd(&bar[XB_TMO], 1u); break; } }
    }
    nloc = mine > 0u ? mine : 1u; nx = cnt > 0u ? cnt : 1u;
}

__device__ __forceinline__ void xcd_barrier(const XcdBarrier& b) {
    asm volatile("s_waitcnt vmcnt(0)" ::: "memory");
    __syncthreads();
    if (threadIdx.x == 0) {
        unsigned* bar = b.bar;
        __builtin_amdgcn_s_waitcnt(0);
        unsigned nloc = b.st[0], nx = b.st[1];
        if (nloc == 0u) { xcd_barrier_complete(bar, b.x, nloc, nx); b.st[0] = nloc; b.st[1] = nx; }
        const unsigned old = xb_add(&bar[XB_XSUB(b.x)], 1u);
        const unsigned gen = old / nloc;
        if (old + 1u == (gen + 1u) * nloc) {
            __builtin_amdgcn_fence(__ATOMIC_RELEASE, "agent");
            asm volatile("s_waitcnt vmcnt(0)" ::: "memory");
            const unsigned og = xb_add(&bar[XB_TOP], 1u);
            const unsigned tg = og / nx;
            if (og + 1u == (tg + 1u) * nx) xb_add(&bar[XB_TOPGEN], 1u);
            else XB_SPIN(xb_ld(&bar[XB_TOPGEN]) == tg, bar);
            __builtin_amdgcn_fence(__ATOMIC_ACQUIRE, "agent");
            xb_add(&bar[XB_XGEN(b.x)], 1u);
            asm volatile("s_waitcnt vmcnt(0)" ::: "memory");
        } else {
            XB_SPIN(xb_ld(&bar[XB_XGEN(b.x)]) == gen, bar);
            __builtin_amdgcn_fence(__ATOMIC_ACQUIRE, "agent");
            asm volatile("s_waitcnt vmcnt(0)" ::: "memory");
        }
    }
    __syncthreads();
}
__device__ __forceinline__ unsigned f2bf(float f) { unsigned u = __builtin_bit_cast(unsigned, f); return (u + 0x7fffu + ((u >> 16) & 1u)) >> 16; }
__device__ __forceinline__ unsigned pk2(float lo, float hi) { return f2bf(lo) | (f2bf(hi) << 16); }
__device__ __forceinline__ void transpose_item(const float* W, int K, int N, int src_col0, const float* kscale, bf16* WT, int dst_row0, int k0, LAS float* scr, int lane) {
    if (src_col0 >= 0) {
#pragma unroll 8
        for (int i = 0; i < 32; ++i) { const int kk = 2 * i + (lane >> 5); float v = W[(size_t)(k0 + kk) * N + src_col0 + (lane & 31)]; if (kscale) v *= kscale[k0 + kk]; scr[kk * 33 + (lane & 31)] = v; }
    } else {
#pragma unroll 8
        for (int i = 0; i < 32; ++i) { const int kk = 2 * i + (lane >> 5); scr[kk * 33 + (lane & 31)] = 0.f; }
    }
    LDS_WAIT(); asm volatile("" ::: "memory");
    const int c = lane & 7;
#pragma unroll
    for (int j = 0; j < 4; ++j) { const int n = (lane >> 3) + 8 * j; const LAS float* s = scr + (8 * c) * 33 + n;
        u32x4 o; o.x = pk2(s[0 * 33], s[1 * 33]); o.y = pk2(s[2 * 33], s[3 * 33]); o.z = pk2(s[4 * 33], s[5 * 33]); o.w = pk2(s[6 * 33], s[7 * 33]);
        *(u32x4*)(WT + (size_t)(dst_row0 + n) * K + k0 + 8 * c) = o; }
    LDS_WAIT(); asm volatile("" ::: "memory");
}
__device__ __forceinline__ int zcol_to_src(int n) {
    if (n < 256) return 384 + n;
    if (n < 768) return 672 + (n - 256);
    if (n < 1280) return 1184 + (n - 768);
    if (n < 1408) return 1696 + (n - 1280);
    if (n < 1536) return 1824 + (n - 1408);
    if (n < 2048) return 1952 + (n - 1536);
    if (n < 2432) return n - 2048;
    if (n < 2464) return 640 + (n - 2432);
    return -1;
}

struct Args { const float* x; const float* c; const int* pos; const float* w_ada; const float* b_ada; const float* norm_gain; const float* w_in; const float* q_gain; const float* kv_gain;
              const float* w_uq; const float* w_ukv; const float* sinks; const float* w_out; const float* final_gain; float* out; unsigned char* ws; int ph_lo, ph_hi, coop, pad; };

constexpr int NPHASE = 7;
constexpr size_t WS_CTL = 15 * MiB, CTL_ZERO_BYTES = 256 * 1024;
constexpr int MISC_OFF = LDS_BYTES - 64;
#ifndef PROBE_REPEAT
#define PROBE_REPEAT -1
#endif
#define REP(k) for (int rep = 0; rep < ((PROBE_REPEAT) == (k) ? 2 : 1); ++rep)
__global__ void __launch_bounds__(512) fwd_kernel(Args a) {
    extern __shared__ __attribute__((aligned(16))) unsigned char lds_raw[];
    LAS unsigned char* lds = (LAS unsigned char*)lds_raw;
    cg::grid_group grid = cg::this_grid();
    const int wave = __builtin_amdgcn_readfirstlane(threadIdx.x >> 6);
#define PH_IDS() const int lane = lane_id_v(), tid = wave * 64 + lane; (void)tid; (void)lane
    const int G = gridDim.x, bx = blockIdx.x;
    unsigned char* ws = a.ws;
    bf16* WT_in = (bf16*)(ws + WS_WIN); bf16* WT_uq = (bf16*)(ws + WS_WUQ); bf16* WT_ukv = (bf16*)(ws + WS_WUKV); bf16* WT_out = (bf16*)(ws + WS_WOUT);
    float* MOD = (float*)(ws + WS_MOD); float* SSQ = (float*)(ws + WS_SSQ); float* SSKV = (float*)(ws + WS_SSKV); float* ROWSS = (float*)(ws + WS_ROWSS);
    float* CS = (float*)(ws + WS_CS); bf16* KPE = (bf16*)(ws + WS_KPE); bf16* H = (bf16*)(ws + WS_H); bf16* Y = (bf16*)(ws + WS_Y); bf16* Z = (bf16*)(ws + WS_Z);
    bf16* Q = (bf16*)(ws + WS_Q); bf16* KV = (bf16*)(ws + WS_KV);
    const int lo = a.ph_lo, hi_ph = a.ph_hi;
    volatile LAS unsigned* MISC = (volatile LAS unsigned*)(lds + MISC_OFF);
    if (threadIdx.x < 16) MISC[threadIdx.x] = 0u;
    __syncthreads();
    XcdBarrier bar; bar.bar = (unsigned*)(ws + WS_CTL); bar.x = 0; bar.st = nullptr;
    if (a.coop) bar = xcd_barrier_post((unsigned*)(ws + WS_CTL), MISC);
#define IN(k) (lo <= (k) && (k) < hi_ph)
#define SEAM(k) do { if (IN(k) && IN((k) + 1)) { if (a.coop == 2) grid.sync(); else xcd_barrier(bar); } } while (0)

    if (IN(0)) REP(0) { PH_IDS();
        LAS float* scr = (LAS float*)(lds + wave * 16384);
        const bool split = G > 96;
        if (!split || bx < 48) {
            for (int u = bx; u < 48; u += (split ? 48 : G)) {
                const int n0 = 64 * u, k0 = 128 * wave;
                for (int idx = lane; idx < 4096; idx += 64) { const float cv = a.c[(idx >> 7) * DM + k0 + (idx & 127)]; scr[idx] = silu_f(cv); }
                LDS_WAIT(); asm volatile("" ::: "memory");
                float acc[32];
#pragma unroll
                for (int b = 0; b < 32; ++b) acc[b] = 0.f;
                for (int k4 = 0; k4 < 32; ++k4) {
                    const float* wp = a.w_ada + (size_t)(k0 + 4 * k4) * (3 * DM) + n0 + lane;
                    const float w0 = wp[0], w1 = wp[3 * DM], w2 = wp[6 * DM], w3 = wp[9 * DM];
#pragma unroll
                    for (int b = 0; b < 32; ++b) { const f32x4 s = *(const LAS f32x4*)(scr + b * 128 + 4 * k4); acc[b] += (s[0] * w0 + s[1] * w1) + (s[2] * w2 + s[3] * w3); }
                }
                __syncthreads();
#pragma unroll
                for (int b = 0; b < 32; ++b) scr[b * 64 + lane] = acc[b];
                __syncthreads();
                for (int o = tid; o < 2048; o += 512) { const int b = o >> 6, n = o & 63; float s = a.b_ada[n0 + n];
#pragma unroll
                    for (int w = 0; w < 8; ++w) s += ((const LAS float*)(lds + w * 16384))[b * 64 + n];
                    MOD[(size_t)b * (3 * DM) + n0 + n] = s; }
                __syncthreads();
            }
        }
        if (!split || bx >= 48) {
            const int nb = split ? G - 48 : G, bb = split ? bx - 48 : bx;
            const int tw = bb * 8 + wave, NTW = nb * 8;
            constexpr int I_IN = 16 * 80, I_UQ = 6 * 24, I_UKV = 4 * 32, I_OUT = 16 * 32;
            for (int it = tw; it < I_IN + I_UQ + I_UKV + I_OUT; it += NTW) {
                int r = it;
                if (r < I_IN) { const int kb = r / 80, nbk = r % 80; transpose_item(a.w_in, DM, NZ_USED, zcol_to_src(32 * nbk), nullptr, WT_in, 32 * nbk, 64 * kb, scr, lane); continue; } r -= I_IN;
                if (r < I_UQ) { const int kb = r / 24, nbk = r % 24; transpose_item(a.w_uq, QLORA, NQ, 32 * nbk, a.q_gain, WT_uq, 32 * nbk, 64 * kb, scr, lane); continue; } r -= I_UQ;
                if (r < I_UKV) { const int kb = r / 32, nbk = r % 32; transpose_item(a.w_ukv, KVLORA, NKV, 32 * nbk, a.kv_gain, WT_ukv, 32 * nbk, 64 * kb, scr, lane); continue; } r -= I_UKV;
                { const int kb = r / 32, nbk = r % 32; transpose_item(a.w_out, DM, DM, 32 * nbk, nullptr, WT_out, 32 * nbk, 64 * kb, scr, lane); }
            }
            const int gt = bb * 512 + tid, NGT = nb * 512;
            for (int idx = gt; idx < MTOK * 16; idx += NGT) { const int mrow = idx >> 4, i = idx & 15;
                const double inv = exp2(-(double)i * (13.287712379549449 / 16.0));
                const double ang = (double)a.pos[mrow] * inv; const double kq = rint(ang * 0.15915494309189535); const float rf = (float)(ang - kq * 6.283185307179586);
                CS[2 * (size_t)idx] = cosf(rf); CS[2 * (size_t)idx + 1] = sinf(rf); }
            for (int idx = gt; idx < 3 * MTOK / 4; idx += NGT) ((f32x4*)SSQ)[idx] = (f32x4){0.f, 0.f, 0.f, 0.f};
        }
    }
    SEAM(0);
    if (IN(1)) REP(1) { PH_IDS();
        const int gw = bx * 8 + wave, NGW = G * 8;
        for (int ch = gw; ch < MTOK / 32; ch += NGW) {
            const int r0 = ch * 32, b = r0 / SEQ; const float* mb = MOD + (size_t)b * (3 * DM);
            f32x4 g1[4], sh[4];
#pragma unroll
            for (int j = 0; j < 4; ++j) { const int col = 4 * lane + 256 * j; const f32x4 gn = *(const f32x4*)(a.norm_gain + col), sc = *(const f32x4*)(mb + DM + col); sh[j] = *(const f32x4*)(mb + col); g1[j] = gn * (sc + 1.0f); }
            for (int r = 0; r < 32; ++r) {
                const f32x4* xr = (const f32x4*)(a.x + (size_t)(r0 + r) * DM) + lane;
                f32x4 v[4]; float s = 0.f;
#pragma unroll
                for (int j = 0; j < 4; ++j) { v[j] = xr[64 * j]; s += (v[j][0] * v[j][0] + v[j][1] * v[j][1]) + (v[j][2] * v[j][2] + v[j][3] * v[j][3]); }
                const float rstd = rsqrtf(wave_sum(s) * (1.0f / DM) + EPSN);
                u32x2* op = (u32x2*)(H + (size_t)(r0 + r) * DM) + lane;
#pragma unroll
                for (int j = 0; j < 4; ++j) { const f32x4 o = v[j] * rstd * g1[j] + sh[j]; u32x2 w; w.x = pk_bf16(o[0], o[1]); w.y = pk_bf16(o[2], o[3]); op[64 * j] = w; }
            }
        }
    }
    SEAM(1);
    if (IN(2)) REP(2) {
        pg8::Gemm g{H, WT_in, MTOK, NZ, DM, DM}; pg8::StaticOrder S; S.init(MTOK, NZ, G, bx);
        pg8::EpiZ E{Z, rep ? nullptr : SSQ, rep ? nullptr : SSKV};
        pg8::gemm_phase<pg8::EpiZ, pg8::StaticOrder, true, true>(lds, g, S, E, wave);
    }
    SEAM(2);
    if (IN(3)) REP(3) {
        { pg8::Gemm g{Z + ZQ_OFF, WT_uq, MTOK, NQ, QLORA, NZ}; pg8::StaticOrder S; S.init(MTOK, NQ, G, bx);
          pg8::EpiQ E{Q, SSQ, CS};
          pg8::gemm_phase<pg8::EpiQ, pg8::StaticOrder, true, true>(lds, g, S, E, wave); }
        { pg8::Gemm g{Z + ZKV_OFF, WT_ukv, MTOK, NKV, KVLORA, NZ}; pg8::StaticOrder S; S.init(MTOK, NKV, G, bx);
          pg8::EpiKV E{KV, SSKV};
          pg8::gemm_phase<pg8::EpiKV, pg8::StaticOrder, true, true>(lds, g, S, E, wave); }
        PH_IDS();
        for (int idx = bx * 512 + tid; idx < MTOK * 16; idx += G * 512) { const int mrow = idx >> 4, i = idx & 15;
            const bf16* zp = Z + (size_t)mrow * NZ + KR_OFF; const float t1 = __uint_as_float((unsigned)zp[i] << 16), t2 = __uint_as_float((unsigned)zp[16 + i] << 16);
            const float cc = CS[2 * (size_t)idx], sn = CS[2 * (size_t)idx + 1];
            KPE[(size_t)mrow * 32 + i] = (bf16)f2bf(t1 * cc - t2 * sn); KPE[(size_t)mrow * 32 + 16 + i] = (bf16)f2bf(t2 * cc + t1 * sn); }
    }
    SEAM(3);
    if (IN(4)) {
        REP(40) for (int u = bx; u < NB * 8 * 8; u += G) { const int bh = u % (NB * 8), qb = 7 - u / (NB * 8); mla_unit(bh >> 3, bh & 7, qb, Q, KV, KPE, Z, Y, lds, wave); }
        REP(41) for (int u = bx; u < NB * 2 * 8; u += G) { swa_unit(u >> 4, (u >> 3) & 1, u & 7, Z, a.pos, a.sinks, Y, lds, wave); }
    }
    SEAM(4);
    if (IN(5)) REP(5) {
        pg8::Gemm g{Y, WT_out, MTOK, DM, DM, DM}; pg8::StaticOrder S; S.init(MTOK, DM, G, bx);
        pg8::EpiOut E{a.x, a.out, MOD, rep ? nullptr : ROWSS};
        pg8::gemm_phase<pg8::EpiOut, pg8::StaticOrder, true, true>(lds, g, S, E, wave);
    }
    SEAM(5);
    if (IN(6)) { PH_IDS();
        for (int idx = bx * 512 + tid; idx < MTOK * (DM / 4); idx += G * 512) { const int row = idx >> 8, c4 = idx & 255;
            const float rstd = rsqrtf(ROWSS[row] * (1.0f / DM) + EPSN); const f32x4 fg = ((const f32x4*)a.final_gain)[c4];
            f32x4* p = (f32x4*)a.out + idx; *p = *p * rstd * fg; }
    }
    if ((PROBE_REPEAT) == 99 && a.coop) { for (int i = 0; i < 6; ++i) xcd_barrier(bar); }
#undef IN
#undef SEAM
}

#ifndef MK_MULTI
#define MK_MULTI 0
#endif
extern "C" void kernel_launch(void* const* d_in, const int* in_sizes, int n_in, void* d_out, int out_size, void* d_ws, size_t ws_size, hipStream_t stream) {
    static int grid = 0;
    if (grid == 0) {
        if (n_in != 14 || in_sizes[0] != MTOK * DM || out_size != MTOK * DM || ws_size < WS_END) { fprintf(stderr, "kernel_launch: unexpected shapes (n_in %d in0 %d out %d ws %zu)\n", n_in, n_in > 0 ? in_sizes[0] : -1, out_size, ws_size); grid = -1; return; }
        int dev = 0, cus = 0, per_cu = 0;
        if (hipGetDevice(&dev) != hipSuccess || hipDeviceGetAttribute(&cus, hipDeviceAttributeMultiprocessorCount, dev) != hipSuccess) { grid = -1; return; }
        if (hipFuncSetAttribute((const void*)fwd_kernel, hipFuncAttributeMaxDynamicSharedMemorySize, LDS_BYTES) != hipSuccess) { fprintf(stderr, "kernel_launch: hipFuncSetAttribute failed\n"); grid = -1; return; }
        if (hipOccupancyMaxActiveBlocksPerMultiprocessor(&per_cu, (const void*)fwd_kernel, 512, LDS_BYTES) != hipSuccess || per_cu < 1) { fprintf(stderr, "kernel_launch: occupancy query says %d\n", per_cu); per_cu = 1; }
        (void)hipGetLastError();
        grid = cus * per_cu;
    }
    if (grid < 0) return;
    Args a{};
    a.x = (const float*)d_in[0]; a.c = (const float*)d_in[1]; a.pos = (const int*)d_in[2]; a.w_ada = (const float*)d_in[3]; a.b_ada = (const float*)d_in[4]; a.norm_gain = (const float*)d_in[5];
    a.w_in = (const float*)d_in[6]; a.q_gain = (const float*)d_in[7]; a.kv_gain = (const float*)d_in[8]; a.w_uq = (const float*)d_in[9]; a.w_ukv = (const float*)d_in[10]; a.sinks = (const float*)d_in[11];
    a.w_out = (const float*)d_in[12]; a.final_gain = (const float*)d_in[13]; a.out = (float*)d_out; a.ws = (unsigned char*)d_ws;
#if MK_MULTI
    for (int p = 0; p < NPHASE; ++p) { a.ph_lo = p; a.ph_hi = p + 1; a.coop = 0; hipLaunchKernelGGL(fwd_kernel, dim3(grid), dim3(512), LDS_BYTES, stream, a); }
#else
    a.ph_lo = 0; a.ph_hi = NPHASE; a.coop = 1;
    if (hipMemsetAsync((char*)d_ws + WS_CTL, 0, CTL_ZERO_BYTES, stream) != hipSuccess) { fprintf(stderr, "kernel_launch: memset failed\n"); return; }
    void* args[] = {&a};
    hipError_t e = hipLaunchCooperativeKernel((const void*)fwd_kernel, dim3(grid), dim3(512), args, LDS_BYTES, stream);
    if (e != hipSuccess) fprintf(stderr, "cooperative launch failed: %s (grid %d)\n", hipGetErrorString(e), grid);
#endif
}
```
